# Optimizing an MI355X kernel written in HIP

```python
import jax, jax.numpy as jnp
from jax import lax
import numpy as np

D_MODEL = 1024
BATCH = 8
SEQ = 4096
DEPTH = 1

GRID_W = 64
CTX_LEN = 256
HEAD_DIM = 64
N_Q_HEADS = 8
N_KV_HEADS = 2
Q_PER_KV = N_Q_HEADS // N_KV_HEADS
ATTN_DIM = N_Q_HEADS * HEAD_DIM
KV_DIM = N_KV_HEADS * HEAD_DIM
WINDOW = 128
ATTN_BLOCK = 128
ATTN_SCALE = HEAD_DIM ** -0.5
ROPE_THETA = 10000.0
POOL_WINDOWS = (2, 4, 8, 16)
N_POOL_GROUPS = len(POOL_WINDOWS)
POOL_DIM = D_MODEL // 2
POOL_GROUP_DIM = POOL_DIM // N_POOL_GROUPS
Q_OFF = 0
K_OFF = Q_OFF + ATTN_DIM
V_OFF = K_OFF + KV_DIM
P_OFF = V_OFF + KV_DIM
GA_OFF = P_OFF + POOL_DIM
GP_OFF = GA_OFF + D_MODEL
IN_DIM = GP_OFF + D_MODEL
N_EXPERTS = 256
TOP_K = 8
N_EXPERT_GROUPS = 8
TOPK_GROUPS = 4
EXPERT_DIM = 256
SHARED_DIM = 256
ROUTED_SCALE = 2.5
EXPERT_BLOCK = 128
N_ADA = 6
NORM_EPS = 1e-6
NEG_INF = -1e30

kernel_name = "hybrid_gated_window_gqa_pool_moe_dit_block"


def _rmsnorm(x, g):
    x32 = x.astype(jnp.float32)
    y = x32 * lax.rsqrt(jnp.mean(x32 * x32, axis=-1, keepdims=True) + NORM_EPS)
    return y.astype(x.dtype) * g


def _axial_rope(seq_len):
    rows = seq_len // GRID_W
    row = jnp.repeat(jnp.arange(rows), GRID_W).astype(jnp.float32)
    col = jnp.tile(jnp.arange(GRID_W), rows).astype(jnp.float32)
    n_freq = HEAD_DIM // 4
    inv = ROPE_THETA ** (-jnp.arange(n_freq, dtype=jnp.float32) / n_freq)
    ang = jnp.stack([row[:, None] * inv, col[:, None] * inv], axis=1)
    return jnp.cos(ang), jnp.sin(ang)


def _apply_rope(x, cos, sin):
    shp = x.shape
    nf = HEAD_DIM // 4
    xr = x.reshape(shp[:-1] + (2, 2, nf))
    bshape = (shp[1],) + (1,) * (x.ndim - 3) + (2, nf)
    c = cos.reshape(bshape).astype(x.dtype)
    s = sin.reshape(bshape).astype(x.dtype)
    a, b = xr[..., 0, :], xr[..., 1, :]
    return jnp.stack([a * c - b * s, b * c + a * s], axis=-2).reshape(shp)


def _window_attention(q, k, v, kc, vc, sink):
    B, S = q.shape[:2]
    C = kc.shape[1]
    nb = S // ATTN_BLOCK
    n_win = 3 * ATTN_BLOCK
    qb = q.reshape(B, nb, ATTN_BLOCK, N_KV_HEADS, Q_PER_KV, HEAD_DIM)

    def band(t):
        tp = jnp.pad(t, ((0, 0), (ATTN_BLOCK, ATTN_BLOCK), (0, 0), (0, 0)))
        tp = tp.reshape(B, nb + 2, ATTN_BLOCK, N_KV_HEADS, HEAD_DIM)
        return jnp.concatenate([tp[:, :-2], tp[:, 1:-1], tp[:, 2:]], axis=2)

    kw, vw = band(k), band(v)
    s_loc = jnp.einsum('bnqkgd,bnjkd->bnkgqj', qb, kw, preferred_element_type=jnp.float32) * ATTN_SCALE
    blk = jnp.arange(nb)[:, None, None]
    qpos = blk * ATTN_BLOCK + jnp.arange(ATTN_BLOCK)[None, :, None]
    kpos = (blk - 1) * ATTN_BLOCK + jnp.arange(n_win)[None, None, :]
    valid = (jnp.abs(qpos - kpos) <= WINDOW) & (kpos >= 0) & (kpos < S)
    s_loc = jnp.where(valid[None, :, None, None], s_loc, NEG_INF)
    s_ctx = jnp.einsum('bnqkgd,bckd->bnkgqc', qb, kc, preferred_element_type=jnp.float32) * ATTN_SCALE
    s_sink = jnp.broadcast_to(sink.astype(jnp.float32)[None, None, :, :, None, None], s_ctx.shape[:-1] + (1,))
    p = jax.nn.softmax(jnp.concatenate([s_loc, s_ctx, s_sink], axis=-1), axis=-1).astype(q.dtype)
    o = (jnp.einsum('bnkgqj,bnjkd->bnqkgd', p[..., :n_win], vw)
         + jnp.einsum('bnkgqc,bckd->bnqkgd', p[..., n_win:n_win + C], vc))
    return o.reshape(B, S, ATTN_DIM)


def _context_attention(qc, kc, vc, sink):
    B, C = qc.shape[:2]
    s = jnp.einsum('bckgd,bjkd->bkgcj', qc, kc, preferred_element_type=jnp.float32) * ATTN_SCALE
    s_sink = jnp.broadcast_to(sink.astype(jnp.float32)[None, :, :, None, None], s.shape[:-1] + (1,))
    p = jax.nn.softmax(jnp.concatenate([s, s_sink], axis=-1), axis=-1)[..., :-1].astype(vc.dtype)
    o = jnp.einsum('bkgcj,bjkd->bckgd', p, vc)
    return o.reshape(B, C, ATTN_DIM)


def _pool_mixer(u, w_pool, pool_scale):
    B, L, _ = u.shape
    u32 = u.astype(jnp.float32)
    cs = jnp.concatenate([jnp.zeros((B, 1, POOL_DIM), jnp.float32), jnp.cumsum(u32, axis=1)], axis=1)
    t = jnp.arange(L)
    groups = []
    for g, w in enumerate(POOL_WINDOWS):
        lo = jnp.clip(t - w // 2, 0, L)
        hi = jnp.clip(t + w // 2, 0, L)
        sl = slice(g * POOL_GROUP_DIM, (g + 1) * POOL_GROUP_DIM)
        csg = cs[:, :, sl]
        mean = (jnp.take(csg, hi, axis=1) - jnp.take(csg, lo, axis=1)) / (hi - lo).astype(jnp.float32)[None, :, None]
        groups.append(mean - u32[:, :, sl])
    d = jnp.stack(groups, axis=2).astype(u.dtype)
    y = jnp.einsum('blgc,gcd->blgd', d, w_pool).reshape(B, L, POOL_DIM)
    return y * pool_scale


def _merge_branches(attn, pool, gate_cols, w_up_attn, w_up_pool, w_out):
    ga, gp = gate_cols[..., :D_MODEL], gate_cols[..., D_MODEL:]
    y = jax.nn.sigmoid(ga) * (attn @ w_up_attn) + jax.nn.sigmoid(gp) * (pool @ w_up_pool)
    return y @ w_out


def _swiglu(x, wg, wu, wd):
    return (jax.nn.silu(x @ wg) * (x @ wu)) @ wd


def _route(h, w_router, router_bias):
    T = h.shape[0]
    s = jax.nn.sigmoid(jnp.einsum('td,de->te', h, w_router, preferred_element_type=jnp.float32))
    sel = s + router_bias.astype(jnp.float32)
    sel_g = sel.reshape(T, N_EXPERT_GROUPS, N_EXPERTS // N_EXPERT_GROUPS)
    group_score = lax.top_k(sel_g, 2)[0].sum(axis=-1)
    _, gidx = lax.top_k(group_score, TOPK_GROUPS)
    gmask = jax.nn.one_hot(gidx, N_EXPERT_GROUPS, dtype=jnp.float32).sum(axis=-2) > 0
    emask = jnp.repeat(gmask, N_EXPERTS // N_EXPERT_GROUPS, axis=-1)
    _, eidx = lax.top_k(jnp.where(emask, sel, NEG_INF), TOP_K)
    w = jnp.take_along_axis(s, eidx, axis=-1)
    w = w / jnp.sum(w, axis=-1, keepdims=True) * ROUTED_SCALE
    return eidx, w


def _moe(h, w_router, router_bias, w_exp_gate, w_exp_up, w_exp_down, w_sh_gate, w_sh_up, w_sh_down):
    T, D = h.shape
    eidx, w = _route(h, w_router, router_bias)
    A = T * TOP_K
    flat_e = eidx.reshape(A)
    flat_tok = jnp.repeat(jnp.arange(T, dtype=jnp.int32), TOP_K)
    flat_w = w.reshape(A)
    order = jnp.argsort(flat_e)
    sorted_e = flat_e[order]
    counts = jnp.bincount(flat_e, length=N_EXPERTS)
    starts = jnp.cumsum(counts) - counts
    padded = (counts + EXPERT_BLOCK - 1) // EXPERT_BLOCK * EXPERT_BLOCK
    pends = jnp.cumsum(padded)
    pstarts = pends - padded
    dest = pstarts[sorted_e] + jnp.arange(A) - starts[sorted_e]
    n_blocks = (A + N_EXPERTS * (EXPERT_BLOCK - 1) + EXPERT_BLOCK - 1) // EXPERT_BLOCK
    n_slots = n_blocks * EXPERT_BLOCK
    slot_tok = jnp.full((n_slots,), T, dtype=jnp.int32).at[dest].set(flat_tok[order])
    slot_w = jnp.zeros((n_slots,), h.dtype).at[dest].set(flat_w[order].astype(h.dtype))
    block_e = jnp.minimum(jnp.searchsorted(pends, jnp.arange(n_blocks) * EXPERT_BLOCK, side='right'), N_EXPERTS - 1)
    h_pad = jnp.concatenate([h, jnp.zeros((1, D), h.dtype)], axis=0)

    def run_block(args):
        tok, wt, e = args
        return _swiglu(h_pad[tok], w_exp_gate[e], w_exp_up[e], w_exp_down[e]) * wt[:, None]

    y = lax.map(run_block, (slot_tok.reshape(n_blocks, EXPERT_BLOCK),
                            slot_w.reshape(n_blocks, EXPERT_BLOCK), block_e))
    routed = jax.ops.segment_sum(y.reshape(n_slots, D), slot_tok, num_segments=T + 1)[:T]
    return routed + _swiglu(h, w_sh_gate, w_sh_up, w_sh_down)


def setup_inputs(seed: int = 0) -> dict:
    key = jax.random.key(seed)
    ks = jax.random.split(key, 24)
    D, E, F = D_MODEL, N_EXPERTS, EXPERT_DIM
    nrm = jax.random.normal
    return {
        "x": nrm(ks[0], (BATCH, SEQ, D), jnp.float32),
        "c": nrm(ks[1], (BATCH, D), jnp.float32),
        "ctx": nrm(ks[2], (BATCH, CTX_LEN, D), jnp.float32),
        "c_ctx": nrm(ks[3], (D,), jnp.float32),
        "w_ada": nrm(ks[4], (DEPTH, D, N_ADA * D), jnp.float32) * (0.5 * D ** -0.5),
        "b_ada": nrm(ks[5], (DEPTH, N_ADA * D), jnp.float32) * 0.02,
        "norm1_g": 1.0 + 0.02 * nrm(ks[6], (DEPTH, D), jnp.float32),
        "w_in": nrm(ks[7], (DEPTH, D, IN_DIM), jnp.float32) * D ** -0.5,
        "attn_sink": nrm(ks[8], (DEPTH, N_Q_HEADS), jnp.float32) * 0.5,
        "w_pool": nrm(ks[9], (DEPTH, N_POOL_GROUPS, POOL_GROUP_DIM, POOL_GROUP_DIM), jnp.float32) * POOL_GROUP_DIM ** -0.5,
        "pool_scale": 1.0 + 0.02 * nrm(ks[10], (DEPTH, POOL_DIM), jnp.float32),
        "w_up_attn": nrm(ks[11], (DEPTH, ATTN_DIM, D), jnp.float32) * ATTN_DIM ** -0.5,
        "w_up_pool": nrm(ks[12], (DEPTH, POOL_DIM, D), jnp.float32) * POOL_DIM ** -0.5,
        "w_out": nrm(ks[13], (DEPTH, D, D), jnp.float32) * D ** -0.5,
        "norm2_g": 1.0 + 0.02 * nrm(ks[14], (DEPTH, D), jnp.float32),
        "w_router": nrm(ks[15], (DEPTH, D, E), jnp.float32) * D ** -0.5,
        "router_bias": nrm(ks[16], (DEPTH, E), jnp.float32) * 0.01,
        "w_exp_gate": nrm(ks[17], (DEPTH, E, D, F), jnp.float32) * D ** -0.5,
        "w_exp_up": nrm(ks[18], (DEPTH, E, D, F), jnp.float32) * D ** -0.5,
        "w_exp_down": nrm(ks[19], (DEPTH, E, F, D), jnp.float32) * F ** -0.5,
        "w_sh_gate": nrm(ks[20], (DEPTH, D, SHARED_DIM), jnp.float32) * D ** -0.5,
        "w_sh_up": nrm(ks[21], (DEPTH, D, SHARED_DIM), jnp.float32) * D ** -0.5,
        "w_sh_down": nrm(ks[22], (DEPTH, SHARED_DIM, D), jnp.float32) * SHARED_DIM ** -0.5,
        "final_g": 1.0 + 0.02 * nrm(ks[23], (D,), jnp.float32),
    }


def reference(x, c, ctx, c_ctx, w_ada, b_ada, norm1_g, w_in, attn_sink, w_pool, pool_scale,
              w_up_attn, w_up_pool, w_out, norm2_g, w_router, router_bias,
              w_exp_gate, w_exp_up, w_exp_down, w_sh_gate, w_sh_up, w_sh_down, final_g):
    B, S, D = x.shape
    C = ctx.shape[1]
    cos, sin = _axial_rope(S)
    for l in range(DEPTH):
        last = l == DEPTH - 1
        mod = (jax.nn.silu(c) @ w_ada[l] + b_ada[l])[:, None, :]
        mod_c = jax.nn.silu(c_ctx) @ w_ada[l] + b_ada[l]
        sh1, sc1, g1, sh2, sc2, g2 = jnp.split(mod, N_ADA, axis=-1)
        sh1c, sc1c, g1c, sh2c, sc2c, g2c = jnp.split(mod_c, N_ADA, axis=-1)

        h = _rmsnorm(x, norm1_g[l]) * (1 + sc1) + sh1
        hc = _rmsnorm(ctx, norm1_g[l]) * (1 + sc1c) + sh1c
        proj = h @ w_in[l]
        q = _apply_rope(proj[..., Q_OFF:K_OFF].reshape(B, S, N_KV_HEADS, Q_PER_KV, HEAD_DIM), cos, sin)
        k = _apply_rope(proj[..., K_OFF:V_OFF].reshape(B, S, N_KV_HEADS, HEAD_DIM), cos, sin)
        v = proj[..., V_OFF:P_OFF].reshape(B, S, N_KV_HEADS, HEAD_DIM)
        kvc = hc @ w_in[l][:, K_OFF:P_OFF]
        kc = kvc[..., :KV_DIM].reshape(B, C, N_KV_HEADS, HEAD_DIM)
        vc = kvc[..., KV_DIM:].reshape(B, C, N_KV_HEADS, HEAD_DIM)
        sink = attn_sink[l].reshape(N_KV_HEADS, Q_PER_KV)
        attn = _window_attention(q, k, v, kc, vc, sink)
        pool = _pool_mixer(proj[..., P_OFF:GA_OFF], w_pool[l], pool_scale[l])
        mix = _merge_branches(attn, pool, proj[..., GA_OFF:IN_DIM], w_up_attn[l], w_up_pool[l], w_out[l])
        x = x + g1 * mix

        h2 = _rmsnorm(x, norm2_g[l]) * (1 + sc2) + sh2
        moe_args = (w_router[l], router_bias[l], w_exp_gate[l], w_exp_up[l], w_exp_down[l],
                    w_sh_gate[l], w_sh_up[l], w_sh_down[l])
        if last:
            f = _moe(h2.reshape(B * S, D), *moe_args).reshape(B, S, D)
        else:
            qc = (hc @ w_in[l][:, Q_OFF:K_OFF]).reshape(B, C, N_KV_HEADS, Q_PER_KV, HEAD_DIM)
            restc = hc @ w_in[l][:, P_OFF:IN_DIM]
            attn_c = _context_attention(qc, kc, vc, sink)
            pool_c = _pool_mixer(restc[..., :POOL_DIM], w_pool[l], pool_scale[l])
            mix_c = _merge_branches(attn_c, pool_c, restc[..., POOL_DIM:], w_up_attn[l], w_up_pool[l], w_out[l])
            ctx = ctx + g1c * mix_c
            h2c = _rmsnorm(ctx, norm2_g[l]) * (1 + sc2c) + sh2c
            fa = _moe(jnp.concatenate([h2.reshape(B * S, D), h2c.reshape(B * C, D)], axis=0), *moe_args)
            f = fa[:B * S].reshape(B, S, D)
            ctx = ctx + g2c * fa[B * S:].reshape(B, C, D)
        x = x + g2 * f
    return _rmsnorm(x, final_g)
```

```cpp
#include <hip/hip_runtime.h>
#include <cstdio>
#include <cstdint>


constexpr int D = 1024, NB = 8, SEQ = 4096, T = NB * SEQ, CTX = 256, TC = NB * CTX;
constexpr int IN_DIM = 3328, NE = 256, TOPK = 8, FE = 256;
constexpr int KROWS = CTX + SEQ;
constexpr int CAP = T;
constexpr float NORM_EPS = 1e-6f;
constexpr float LOG2E = 1.4426950408889634f;
constexpr float WQ8 = 64.0f, AQ8 = 4.0f;
constexpr float WDQ8 = 32.0f, HQ8 = 8.0f;
constexpr float QSCALE = 0.125f * LOG2E;

constexpr size_t MiB = 1u << 20;
constexpr size_t WS_CNT = 0;
constexpr size_t WS_ROPE = 4096;
constexpr size_t WS_MOD = 16384;
constexpr size_t WS_BAR = 512 * 1024;
constexpr size_t WS_PCNT = WS_BAR + 16384;
constexpr size_t WS_BAR_BYTES = 16384 + 32768;
constexpr size_t WS_SLOT = 1 * MiB;
constexpr size_t WS_WIN = 2 * MiB;
constexpr size_t WS_WUA = 9 * MiB;
constexpr size_t WS_WEFF = 10 * MiB;
constexpr size_t WS_WOUT = 11 * MiB;
constexpr size_t WS_WR = 13 * MiB;
constexpr size_t WS_WD = 14 * MiB;
constexpr size_t WS_WGU = 143 * MiB;
constexpr size_t WS_Y = 143 * MiB;
constexpr size_t WS_G = 400 * MiB;
constexpr size_t WS_LOGIT = 400 * MiB;
constexpr size_t WS_X1B = 464 * MiB;
constexpr size_t WS_H2Q = 432 * MiB;
constexpr size_t WS_H = 528 * MiB;
constexpr size_t WS_Q = 596 * MiB;
constexpr size_t WS_AO = 628 * MiB;
constexpr size_t WS_U = 660 * MiB;
constexpr size_t WS_DP = 692 * MiB;
constexpr size_t WS_K = 724 * MiB;
constexpr size_t WS_V = 733 * MiB;
constexpr size_t WS_T1 = 742 * MiB;
constexpr size_t WS_YSH = 655 * MiB;
constexpr size_t WS_HB = 719 * MiB;
constexpr size_t WS_LDST = 895 * MiB;
constexpr size_t WS_LW = 927 * MiB;
constexpr size_t WS_H2 = 959 * MiB;
constexpr size_t WS_END = 1023 * MiB;

#define LAS __attribute__((address_space(3)))
typedef unsigned short bf16;
typedef short bf16x8 __attribute__((ext_vector_type(8)));
typedef float f32x4 __attribute__((ext_vector_type(4)));
typedef float f32x2 __attribute__((ext_vector_type(2)));
typedef unsigned u32x4 __attribute__((ext_vector_type(4)));
typedef unsigned u32x2 __attribute__((ext_vector_type(2)));
typedef __bf16 bf16x2_t __attribute__((ext_vector_type(2)));

__device__ __forceinline__ unsigned pk2(float lo, float hi) { f32x2 v = {lo, hi}; bf16x2_t b = __builtin_convertvector(v, bf16x2_t); return __builtin_bit_cast(unsigned, b); }
__device__ __forceinline__ float bflo(unsigned u) { return __uint_as_float(u << 16); }
__device__ __forceinline__ float bfhi(unsigned u) { return __uint_as_float(u & 0xffff0000u); }
__device__ __forceinline__ float bf2f(bf16 h) { return __uint_as_float((unsigned)h << 16); }
__device__ __forceinline__ float sigmoidf_(float x) { return __builtin_amdgcn_rcpf(1.0f + __builtin_amdgcn_exp2f(x * -LOG2E)); }
__device__ __forceinline__ float wave_sum(float v) {
#pragma unroll
    for (int o = 1; o < 64; o <<= 1) v += __shfl_xor(v, o);
    return v;
}
__host__ __device__ __forceinline__ int invperm32(int c) { return 16 * ((c >> 2) & 1) + 4 * (c >> 3) + (c & 3); }

#define OPAQUE_V(x) asm volatile("" : "+v"(x))
__device__ __forceinline__ int lane_id() { int l = __builtin_amdgcn_mbcnt_hi(~0u, __builtin_amdgcn_mbcnt_lo(~0u, 0u)); OPAQUE_V(l); return l; }
struct Params { const float* in[24]; float* out; unsigned char* ws; };

struct Unit { int pm, pn, e, rt, seq; };

__device__ __forceinline__ void static_unit(int L, int nM, int nN, int& pm, int& pn) {
    const int nwg = nM * nN; int wgid = L;
    { const int q = nwg / 8, r = nwg % 8, xcd = wgid % 8, off = wgid / 8; wgid = (xcd < r ? xcd * (q + 1) : r * (q + 1) + (xcd - r) * q) + off; }
    const int nig = 8 * nN, gid = wgid / nig, fm = gid * 8, gsz = (nM - fm) < 8 ? (nM - fm) : 8;
    pm = fm + ((wgid % nig) % gsz); pn = (wgid % nig) / gsz;
}

struct DenseSched {
    static constexpr bool LATE_OFF = true;
    const void* A; const void* Bt; int KB, nM, nN, G, c; int extra, extra_pm0, extra_pn;
    __device__ __forceinline__ bool next(int i, Unit& u) const {
        const int L = i * G + c; const int nwg = nM * nN;
        if (L >= nwg + extra) return false;
        if (L < nwg) static_unit(L, nM, nN, u.pm, u.pn); else { u.pm = extra_pm0 + (L - nwg); u.pn = extra_pn; }
        u.e = 0; u.rt = 0; return true;
    }
    __device__ __forceinline__ unsigned a_off(const Unit& u, int r) const { return (unsigned)(u.pm * 256 + r) * (unsigned)KB; }
    __device__ __forceinline__ const char* b_tile(const Unit& u) const { return (const char*)Bt + (size_t)u.pn * 256 * KB; }
};

struct PairSched {
    static constexpr bool LATE_OFF = true;
    const void* A; const void* A1; const void* Bt; const void* Bt1; int KB, nM, nN, G, c;
    __device__ __forceinline__ bool next(int i, Unit& u) const {
        const int nwg = nM * nN, per = (nwg - c + G - 1) / G;
        if (i >= 2 * per) return false;
        const int mode = i >= per, L = (mode ? i - per : i) * G + c;
        static_unit(L, nM, nN, u.pm, u.pn); u.e = mode; u.rt = 0; return true;
    }
    __device__ __forceinline__ unsigned a_off(const Unit& u, int r) const { return (unsigned)((u.e ? (const char*)A1 - (const char*)A : 0) + (size_t)(u.pm * 256 + r) * KB); }
    __device__ __forceinline__ const char* b_tile(const Unit& u) const { return (const char*)(u.e ? Bt1 : Bt) + (size_t)u.pn * 256 * KB; }
};

struct GroupSched {
    static constexpr bool LATE_OFF = false;
    const LAS int* tp; const LAS int* cnt;
    const void* A; const void* Bt; const int* ldst;
    int KB, npn, G, vcu; size_t bstride; bool gather;
    __device__ __forceinline__ bool next(int i, Unit& u) const {
        const int L = i * G + vcu; const int total = tp[257] * npn;
        if (L >= total) return false;
        int lo = 0, hi = 257;
        while (hi - lo > 1) { const int mid = (lo + hi) >> 1; if (npn * tp[mid] <= L) lo = mid; else hi = mid; }
        const int e = lo, nt = tp[e + 1] - tp[e], r = L - npn * tp[e];
        u.e = e; u.pn = r / nt; u.rt = r % nt; u.pm = tp[e] + u.rt; return true;
    }
    __device__ __forceinline__ unsigned a_off(const Unit& u, int r) const {
        if (!gather) return (unsigned)(u.pm * 256 + r) * (unsigned)KB;
        const int idx = u.rt * 256 + r; int tok;
        if (u.e == 256) tok = idx; else tok = (idx < cnt[u.e]) ? (ldst[(size_t)u.e * CAP + idx] >> 3) : 0;
        return (unsigned)tok * (unsigned)KB;
    }
    __device__ __forceinline__ const char* b_tile(const Unit& u) const { return (const char*)Bt + (size_t)u.e * bstride + (size_t)u.pn * 256 * KB; }
};

constexpr int LDS_TAB_OFF = 131072;
typedef f32x4 Acc[2][2][4][2];

struct EpiProj {
    static constexpr bool FUSED = false;
    __device__ __forceinline__ void unit_begin(const Unit&, LAS unsigned char*, int, int) const {}
    bf16 *Q, *Kb, *Vb, *U, *Gt; const f32x2* rope;
    __device__ __forceinline__ void operator()(const Acc& acc, const Unit& u, int wr, int wc, int fr, int fq) const {
        const int pn = u.pn; const int row0 = u.pm * 256 + wr * 64 + fr;
        if (pn <= 2) {
            const bool isx = row0 < T;
            f32x2 cs[2][4][4];
            if (isx) {
#pragma unroll
                for (int ai = 0; ai < 2; ++ai)
#pragma unroll
                    for (int m = 0; m < 4; ++m) { const int s_ = (row0 + ai * 128 + m * 16) & (SEQ - 1); const int pos = (wc & 1) ? (s_ & 63) : (s_ >> 6);
#pragma unroll
                        for (int j = 0; j < 4; ++j) cs[ai][m][j] = rope[pos * 16 + 4 * fq + j]; }
            }
#pragma unroll
            for (int ai = 0; ai < 2; ++ai)
#pragma unroll
                for (int m = 0; m < 4; ++m) {
                    const int rg = row0 + ai * 128 + m * 16; const int s_ = rg & (SEQ - 1);
#pragma unroll
                    for (int bj = 0; bj < 2; ++bj) {
                        f32x4 a = acc[ai][bj][m][0], b = acc[ai][bj][m][1];
                        const bool isv = (pn == 2 && bj == 1);
                        if (!isv && isx) {
#pragma unroll
                            for (int j = 0; j < 4; ++j) { const f32x2 c = cs[ai][m][j]; const float a0 = a[j], b0 = b[j]; a[j] = a0 * c.x - b0 * c.y; b[j] = b0 * c.x + a0 * c.y; }
                        }
                        bf16* dst;
                        if (pn < 2) { a = a * QSCALE; b = b * QSCALE; dst = Q + (size_t)rg * 512 + pn * 256 + bj * 128 + wc * 32 + 4 * fq; }
                        else {
                            size_t krow; if (isx) krow = (size_t)(rg >> 12) * KROWS + CTX + s_; else { const int j2 = rg - T; krow = (size_t)(j2 >> 8) * KROWS + (j2 & 255); }
                            dst = (bj == 0 ? Kb : Vb) + krow * 128 + wc * 32 + 4 * fq;
                        }
                        u32x2 w0, w1; w0.x = pk2(a[0], a[1]); w0.y = pk2(a[2], a[3]); w1.x = pk2(b[0], b[1]); w1.y = pk2(b[2], b[3]);
                        *(u32x2*)dst = w0; *(u32x2*)(dst + 16) = w1;
                    }
                }
        } else if (pn < 5) {
#pragma unroll
            for (int ai = 0; ai < 2; ++ai)
#pragma unroll
                for (int m = 0; m < 4; ++m) { const size_t rg = (size_t)(row0 + ai * 128 + m * 16);
#pragma unroll
                    for (int bj = 0; bj < 2; ++bj) { const f32x4 a = acc[ai][bj][m][0], b = acc[ai][bj][m][1];
                        u32x4 w; w.x = pk2(a[0], a[1]); w.y = pk2(a[2], a[3]); w.z = pk2(b[0], b[1]); w.w = pk2(b[2], b[3]);
                        *(u32x4*)(U + rg * 512 + (pn - 3) * 256 + bj * 128 + wc * 32 + 8 * fq) = w; } }
        } else {
#pragma unroll
            for (int ai = 0; ai < 2; ++ai)
#pragma unroll
                for (int m = 0; m < 4; ++m) { const size_t rg = (size_t)(row0 + ai * 128 + m * 16);
#pragma unroll
                    for (int bj = 0; bj < 2; ++bj) { const f32x4 a = acc[ai][bj][m][0], b = acc[ai][bj][m][1];
                        u32x4 w; w.x = pk2(a[0], a[1]); w.y = pk2(a[2], a[3]); w.z = pk2(b[0], b[1]); w.w = pk2(b[2], b[3]);
                        *(u32x4*)(Gt + rg * 2048 + (pn - 5) * 256 + bj * 128 + wc * 32 + 8 * fq) = w; } }
        }
    }
};

struct EpiGate {
    static constexpr bool FUSED = false;
    __device__ __forceinline__ void unit_begin(const Unit&, LAS unsigned char*, int, int) const {}
    bf16* T1; const bf16* Gt;
    __device__ __forceinline__ void operator()(const Acc& acc, const Unit& u, int wr, int wc, int fr, int fq) const {
        const int col0 = u.pn * 256 + wc * 32 + 8 * fq; const int mode = u.e;
#pragma unroll
        for (int ai = 0; ai < 2; ++ai)
#pragma unroll
            for (int mh = 0; mh < 2; ++mh) {
                u32x4 g[2][2], t[2][2];
#pragma unroll
                for (int m2 = 0; m2 < 2; ++m2) { const size_t rg = (size_t)(u.pm * 256 + ai * 128 + wr * 64 + (mh * 2 + m2) * 16 + fr);
#pragma unroll
                    for (int bj = 0; bj < 2; ++bj) { g[m2][bj] = *(const u32x4*)(Gt + rg * 2048 + mode * 1024 + col0 + bj * 128); t[m2][bj] = (u32x4){0u, 0u, 0u, 0u}; if (mode) t[m2][bj] = *(const u32x4*)(T1 + rg * 1024 + col0 + bj * 128); } }
#pragma unroll
                for (int m2 = 0; m2 < 2; ++m2) { const int m = mh * 2 + m2; const size_t rg = (size_t)(u.pm * 256 + ai * 128 + wr * 64 + m * 16 + fr);
#pragma unroll
                    for (int bj = 0; bj < 2; ++bj) {
                        const f32x4 a = acc[ai][bj][m][0], b = acc[ai][bj][m][1]; const u32x4 gg = g[m2][bj], tt = t[m2][bj];
                        float v[8] = {a[0] * sigmoidf_(bflo(gg.x)), a[1] * sigmoidf_(bfhi(gg.x)), a[2] * sigmoidf_(bflo(gg.y)), a[3] * sigmoidf_(bfhi(gg.y)), b[0] * sigmoidf_(bflo(gg.z)), b[1] * sigmoidf_(bfhi(gg.z)), b[2] * sigmoidf_(bflo(gg.w)), b[3] * sigmoidf_(bfhi(gg.w))};
                        v[0] += bflo(tt.x); v[1] += bfhi(tt.x); v[2] += bflo(tt.y); v[3] += bfhi(tt.y); v[4] += bflo(tt.z); v[5] += bfhi(tt.z); v[6] += bflo(tt.w); v[7] += bfhi(tt.w);
                        u32x4 w; w.x = pk2(v[0], v[1]); w.y = pk2(v[2], v[3]); w.z = pk2(v[4], v[5]); w.w = pk2(v[6], v[7]);
                        *(u32x4*)(T1 + rg * 1024 + col0 + bj * 128) = w;
                    } }
                asm volatile("" ::: "memory");
            }
    }
};

struct EpiX1F {
    static constexpr bool FUSED = true;
    __device__ __forceinline__ void unit_begin(const Unit&, LAS unsigned char*, int, int) const {}
    const float* x; const float* mod; bf16* x1; bf16* H2; const float* g2n; float* slot; unsigned* pcnt; unsigned char* H2q;
    __device__ __forceinline__ void fused(Acc& acc, const Unit& u, int wr, int wc, int fr_, int fq_, LAS unsigned char* lds, int wid, int lane_) const {
        const int lane1 = lane_id(), fr = lane1 & 15, fq = lane1 >> 4;
        LAS float* P = (LAS float*)(lds + LDS_TAB_OFF + 8192);
        LAS float* S = (LAS float*)(lds + LDS_TAB_OFF + 12288);
        LAS unsigned* flag = (LAS unsigned*)(lds + LDS_TAB_OFF + 13312);
        const int col0 = u.pn * 256 + wc * 32 + 8 * fq; const int b = (u.pm * 256) >> 12; const float* mb = mod + b * 6144;
        { f32x4 g[2][2];
#pragma unroll
          for (int bj = 0; bj < 2; ++bj)
#pragma unroll
              for (int n = 0; n < 2; ++n) g[bj][n] = *(const f32x4*)(mb + 2048 + col0 + bj * 128 + n * 4);
#pragma unroll
          for (int ai = 0; ai < 2; ++ai) {
              f32x4 xv[4][2][2];
#pragma unroll
              for (int m = 0; m < 4; ++m) { const float* xp = x + (size_t)(u.pm * 256 + ai * 128 + wr * 64 + m * 16 + fr) * D + col0;
#pragma unroll
                  for (int bj = 0; bj < 2; ++bj)
#pragma unroll
                      for (int n = 0; n < 2; ++n) xv[m][bj][n] = *(const f32x4*)(xp + bj * 128 + n * 4); }
#pragma unroll
              for (int m = 0; m < 4; ++m) {
#pragma unroll
                  for (int bj = 0; bj < 2; ++bj)
#pragma unroll
                      for (int n = 0; n < 2; ++n) acc[ai][bj][m][n] = xv[m][bj][n] + g[bj][n] * acc[ai][bj][m][n];
                  asm volatile("" : "+v"(acc[ai][0][m][0]), "+v"(acc[ai][0][m][1]), "+v"(acc[ai][1][m][0]), "+v"(acc[ai][1][m][1]));
              }
              asm volatile("" ::: "memory");
          } }
        { const int l2 = lane_id(), fr = l2 & 15, fq = l2 >> 4;
#pragma unroll
        for (int ai = 0; ai < 2; ++ai)
#pragma unroll
            for (int m = 0; m < 4; ++m) { float q = 0.f;
#pragma unroll
                for (int bj = 0; bj < 2; ++bj)
#pragma unroll
                    for (int n = 0; n < 2; ++n) { const f32x4 v = acc[ai][bj][m][n]; q += (v[0] * v[0] + v[1] * v[1]) + (v[2] * v[2] + v[3] * v[3]); }
                q += __shfl_xor(q, 16); q += __shfl_xor(q, 32);
                if (fq == 0) P[(ai * 128 + wr * 64 + m * 16 + fr) * 4 + wc] = q; } }
        asm volatile("s_waitcnt lgkmcnt(0)" ::: "memory"); __builtin_amdgcn_s_barrier(); asm volatile("" ::: "memory");
        const int lane = lane_id(); const int row = wid * 32 + (lane & 31);
        if (lane < 32) { const float t = (P[row * 4 + 0] + P[row * 4 + 1]) + (P[row * 4 + 2] + P[row * 4 + 3]);
            __hip_atomic_store(slot + ((size_t)(u.pm * 256 + row) * 4 + u.pn), t, __ATOMIC_RELAXED, __HIP_MEMORY_SCOPE_AGENT); }
        asm volatile("s_waitcnt vmcnt(0)" ::: "memory");
        if (lane == 0) __hip_atomic_fetch_add(pcnt + 64 * u.pm, 1u, __ATOMIC_RELAXED, __HIP_MEMORY_SCOPE_AGENT);
        if (wid == 0) {
            unsigned spins = 0;
            while ((unsigned)__builtin_amdgcn_readfirstlane(__hip_atomic_load(pcnt + 64 * u.pm, __ATOMIC_RELAXED, __HIP_MEMORY_SCOPE_AGENT)) < 32u) { __builtin_amdgcn_s_sleep(2); if (++spins > (1u << 20)) break; }
            (void)flag; (void)spins;
        }
        asm volatile("s_waitcnt vmcnt(0) lgkmcnt(0)" ::: "memory"); __builtin_amdgcn_s_barrier(); asm volatile("" ::: "memory");
        if (lane < 32) { const float* sl = slot + (size_t)(u.pm * 256 + row) * 4; float t = 0.f;
#pragma unroll
            for (int k = 0; k < 4; ++k) t += __hip_atomic_load(sl + k, __ATOMIC_RELAXED, __HIP_MEMORY_SCOPE_AGENT);
            S[row] = 1.0f / sqrtf(t * (1.0f / D) + NORM_EPS); }
        asm volatile("s_waitcnt lgkmcnt(0)" ::: "memory"); __builtin_amdgcn_s_barrier(); asm volatile("" ::: "memory");
        const int l6 = lane_id(); const int fr6 = l6 & 15; const int c6 = u.pn * 256 + wc * 32 + 8 * (l6 >> 4);
#pragma unroll
        for (int bj = 0; bj < 2; ++bj) {
            f32x4 gs[2], sh[2];
#pragma unroll
            for (int n = 0; n < 2; ++n) { const int c = c6 + bj * 128 + n * 4; gs[n] = *(const f32x4*)(g2n + c) * (*(const f32x4*)(mb + 4096 + c) + 1.0f); sh[n] = *(const f32x4*)(mb + 3072 + c); }
#pragma unroll
            for (int ai = 0; ai < 2; ++ai) {
#pragma unroll
                for (int m = 0; m < 4; ++m) { const int r = ai * 128 + wr * 64 + m * 16 + fr6; const size_t rg = (size_t)(u.pm * 256 + r); const float rstd = S[r];
                    const f32x4 v0 = acc[ai][bj][m][0], v1 = acc[ai][bj][m][1];
                    { u32x4 xw; xw.x = pk2(v0[0], v0[1]); xw.y = pk2(v0[2], v0[3]); xw.z = pk2(v1[0], v1[1]); xw.w = pk2(v1[2], v1[3]); *(u32x4*)(x1 + rg * D + c6 + bj * 128) = xw; }
                    const f32x4 h0 = (v0 * rstd) * gs[0] + sh[0], h1 = (v1 * rstd) * gs[1] + sh[1];
                    u32x4 w; w.x = pk2(h0[0], h0[1]); w.y = pk2(h0[2], h0[3]); w.z = pk2(h1[0], h1[1]); w.w = pk2(h1[2], h1[3]);
                    *(u32x4*)(H2 + rg * D + c6 + bj * 128) = w;
                    { f32x4 q0 = h0 * AQ8, q1 = h1 * AQ8;
#pragma unroll
                      for (int j = 0; j < 4; ++j) { q0[j] = fminf(fmaxf(q0[j], -448.0f), 448.0f); q1[j] = fminf(fmaxf(q1[j], -448.0f), 448.0f); }
                      int lo = 0, hi = 0; lo = __builtin_amdgcn_cvt_pk_fp8_f32(q0[0], q0[1], lo, false); lo = __builtin_amdgcn_cvt_pk_fp8_f32(q0[2], q0[3], lo, true);
                      hi = __builtin_amdgcn_cvt_pk_fp8_f32(q1[0], q1[1], hi, false); hi = __builtin_amdgcn_cvt_pk_fp8_f32(q1[2], q1[3], hi, true);
                      *(u32x2*)(H2q + rg * D + c6 + bj * 128) = (u32x2){(unsigned)lo, (unsigned)hi}; } }
                asm volatile("" ::: "memory");
            }
        }
    }
};

struct EpiLogit {
    static constexpr bool FUSED = false;
    __device__ __forceinline__ void unit_begin(const Unit&, LAS unsigned char*, int, int) const {}
    float* L;
    __device__ __forceinline__ void operator()(const Acc& acc, const Unit& u, int wr, int wc, int fr, int fq) const {
#pragma unroll
        for (int ai = 0; ai < 2; ++ai)
#pragma unroll
            for (int m = 0; m < 4; ++m) {
                const int rg = u.pm * 256 + ai * 128 + wr * 64 + m * 16 + fr;
#pragma unroll
                for (int bj = 0; bj < 2; ++bj)
#pragma unroll
                    for (int n = 0; n < 2; ++n) *(f32x4*)(L + (size_t)rg * 256 + bj * 128 + wc * 32 + n * 16 + 4 * fq) = acc[ai][bj][m][n];

            }
    }
};

struct EpiH {
    static constexpr bool FUSED = false;
    __device__ __forceinline__ void unit_begin(const Unit&, LAS unsigned char*, int, int) const {}
    unsigned char* Hq; float ascale;
    __device__ __forceinline__ void operator()(const Acc& acc, const Unit& u, int wr, int wc, int fr, int fq) const {
#pragma unroll
        for (int ai = 0; ai < 2; ++ai)
#pragma unroll
            for (int m = 0; m < 4; ++m) {
                const int row = u.pm * 256 + ai * 128 + wr * 64 + m * 16 + fr;
                float v[8];
#pragma unroll
                for (int n = 0; n < 2; ++n)
#pragma unroll
                    for (int j = 0; j < 4; ++j) { const float g = acc[ai][0][m][n][j] * ascale, up = acc[ai][1][m][n][j] * ascale; v[4 * n + j] = fminf(fmaxf(g * sigmoidf_(g) * up * HQ8, -448.0f), 448.0f); }
                int lo = 0, hi = 0;
                lo = __builtin_amdgcn_cvt_pk_fp8_f32(v[0], v[1], lo, false); lo = __builtin_amdgcn_cvt_pk_fp8_f32(v[2], v[3], lo, true);
                hi = __builtin_amdgcn_cvt_pk_fp8_f32(v[4], v[5], hi, false); hi = __builtin_amdgcn_cvt_pk_fp8_f32(v[6], v[7], hi, true);
                *(u32x2*)(Hq + (size_t)row * 256 + u.pn * 128 + wc * 32 + 8 * fq) = (u32x2){(unsigned)lo, (unsigned)hi};
            }
    }
};

constexpr float YSCALE = 16.0f;
struct EpiY {
    unsigned char* Y; unsigned char* Ysh; const int* ldst; const float* lw; const LAS int* cnt; float ascale;
    static constexpr bool FUSED = false;
    static constexpr int RI = LDS_TAB_OFF + 8192;
    __device__ __forceinline__ void unit_begin(const Unit& u, LAS unsigned char* lds, int wid, int lane) const {
        if (u.e < 256) {
            const size_t base = (size_t)u.e * CAP + u.rt * 256 + 64 * (wid & 3) + lane;
            LAS unsigned char* d = lds + RI + (u.seq & 1) * 2048 + (wid >> 2) * 1024 + (wid & 3) * 256;
            if (wid < 4) __builtin_amdgcn_global_load_lds((const unsigned*)(ldst + base), (LAS unsigned*)d, 4, 0, 0);
            else __builtin_amdgcn_global_load_lds((const unsigned*)(lw + base), (LAS unsigned*)d, 4, 0, 0);
        }
    }
    __device__ __forceinline__ void operator()(const Acc& acc, const Unit& u, int wr, int wc, int fr, int fq) const {
        const LAS int* rdst = (const LAS int*)((LAS unsigned char*)cnt - 2048 + 8192 + (u.seq & 1) * 2048); const LAS float* rw = (const LAS float*)(rdst + 256);
        const int ce = cnt[u.e];
#pragma unroll
        for (int ai = 0; ai < 2; ++ai)
#pragma unroll
            for (int m = 0; m < 4; ++m) {
                const int r = ai * 128 + wr * 64 + m * 16 + fr, idx = u.rt * 256 + r;
                unsigned char* rowp; float w;
                if (u.e == 256) { rowp = Ysh + (size_t)idx * 1024; w = YSCALE * ascale; }
                else { if (idx >= ce) continue; rowp = Y + (size_t)rdst[r] * 1024; w = rw[r] * (YSCALE * ascale); }
                u32x4 o;
#pragma unroll
                for (int bj = 0; bj < 2; ++bj)
#pragma unroll
                    for (int n = 0; n < 2; ++n) { f32x4 a = acc[ai][bj][m][n] * w;
#pragma unroll
                        for (int j = 0; j < 4; ++j) a[j] = fminf(fmaxf(a[j], -448.0f), 448.0f);
                        int pk = 0; pk = __builtin_amdgcn_cvt_pk_fp8_f32(a[0], a[1], pk, false); pk = __builtin_amdgcn_cvt_pk_fp8_f32(a[2], a[3], pk, true); o[bj * 2 + n] = (unsigned)pk; }
                *(u32x4*)(rowp + u.pn * 256 + wc * 64 + 16 * fq) = o;
            }
    }
};

constexpr int BK = 64, HALF = 128, HTB = HALF * BK * 2;
__device__ __forceinline__ int lds_byte(int r, int c) { const int st = (r >> 4) * 2 + (c >> 5), rr = r & 15, cc = c & 31, ob = rr * 64 + cc * 2; return st * 1024 + (ob ^ (((ob >> 9) & 1) << 5)); }
__device__ __forceinline__ void stage_rc(int b, int& R, int& C) { const int st = b / 1024, sb = b % 1024, swz = sb ^ (((sb >> 9) & 1) << 5); R = (st >> 1) * 16 + swz / 64; C = (st & 1) * 32 + (swz % 64) / 2; }

typedef int i32x8 __attribute__((ext_vector_type(8)));
typedef int i32x4 __attribute__((ext_vector_type(4)));
template <class Sched, class Epi, bool FP8 = false>
__device__ __forceinline__ void gemm_mfma(LAS unsigned char* lds, const Sched& S, const Epi& E, const int KB, const int wid) {
    const int lane = lane_id(), tid = wid * 64 + lane, wr = wid >> 2, wc = wid & 3, fr = lane & 15, fq = lane >> 4;
    const int nt = KB / (BK * 2);
    int sR[2], sC[2]; unsigned voffB[2];
#pragma unroll
    for (int i = 0; i < 2; ++i) { stage_rc(tid * 16 + i * 8192, sR[i], sC[i]); voffB[i] = (unsigned)(sR[i] * KB + sC[i] * 2); }
    const size_t kstep = (size_t)(BK * 2);
    const size_t hstep = (size_t)HALF * KB;
    const unsigned ldsw = (unsigned)wid * 1024u;
    const int aoff = FP8 ? lds_byte(wr * 64 + fr, fq * 16) : lds_byte(wr * 64 + fr, fq * 8), boff = FP8 ? lds_byte(wc * 32 + fr, fq * 16) : lds_byte(wc * 32 + fr, fq * 8);
    const int aoff1 = lds_byte(wr * 64 + fr, fq * 16 + 8), boff1 = lds_byte(wc * 32 + fr, fq * 16 + 8);
    const char* Abase = (const char*)S.A;
#define G_SA(b, h) (((b) * 2 + (h)) * HTB)
#define G_SB(b, h) ((4 + (b) * 2 + (h)) * HTB)
#define G_STAGE(bufoff, gbase, voff) do { _Pragma("unroll") for (int _i = 0; _i < 2; ++_i) \
        __builtin_amdgcn_global_load_lds((const unsigned*)((const char*)(gbase) + (voff)[_i]), (LAS unsigned*)(lds + (bufoff) + ldsw + _i * 8192), 16, 0, 0); } while (0)
#define G_LD8(dst, p0, p1) do { const i32x4 c0_ = *(const LAS i32x4*)(p0), c1_ = *(const LAS i32x4*)(p1); dst = __builtin_shufflevector(c0_, c1_, 0, 1, 2, 3, 4, 5, 6, 7); } while (0)
#define G_LDA(dst, b, h) do { _Pragma("unroll") for (int m = 0; m < 4; ++m) { if constexpr (FP8) G_LD8(dst##8[m], lds + G_SA(b, h) + aoff + m * 2048, lds + G_SA(b, h) + aoff1 + m * 2048); \
        else { _Pragma("unroll") for (int k = 0; k < 2; ++k) dst[m][k] = *(const LAS bf16x8*)(lds + G_SA(b, h) + aoff + m * 2048 + k * 1024); } } } while (0)
#define G_LDB(dst, b, h) do { _Pragma("unroll") for (int n = 0; n < 2; ++n) { if constexpr (FP8) G_LD8(dst##8[n], lds + G_SB(b, h) + boff + n * 2048, lds + G_SB(b, h) + boff1 + n * 2048); \
        else { _Pragma("unroll") for (int k = 0; k < 2; ++k) dst[n][k] = *(const LAS bf16x8*)(lds + G_SB(b, h) + boff + n * 2048 + k * 1024); } } } while (0)
#define G_MMA(ai, bj, At, Bt) do { __builtin_amdgcn_s_setprio(1); _Pragma("unroll") for (int m = 0; m < 4; ++m) _Pragma("unroll") for (int n = 0; n < 2; ++n) { \
        if constexpr (FP8) asm volatile("v_mfma_scale_f32_16x16x128_f8f6f4 %0, %1, %2, %0, %3, %3 op_sel_hi:[0,0,0]" : "+v"(acc[ai][bj][m][n]) : "v"(Bt##8[n]), "v"(At##8[m]), "v"(one8)); \
        else { _Pragma("unroll") for (int k = 0; k < 2; ++k) acc[ai][bj][m][n] = __builtin_amdgcn_mfma_f32_16x16x32_bf16(Bt[n][k], At[m][k], acc[ai][bj][m][n], 0, 0, 0); } } \
        __builtin_amdgcn_s_setprio(0); } while (0)
#define G_WAIT_V(n) asm volatile("s_waitcnt vmcnt(" #n ")" ::: "memory")
#define G_WAIT_L(n) asm volatile("s_waitcnt lgkmcnt(" #n ")" ::: "memory")
#define G_BAR __builtin_amdgcn_s_barrier()
#define G_SCHED __builtin_amdgcn_sched_barrier(0)
    Unit cur, nxt; int ui = 0;
    if (!S.next(0, cur)) return;
    cur.seq = 0; E.unit_begin(cur, lds, wid, lane);
    Acc acc;
#pragma unroll
    for (int a = 0; a < 2; ++a)
#pragma unroll
        for (int b = 0; b < 2; ++b)
#pragma unroll
            for (int m = 0; m < 4; ++m)
#pragma unroll
                for (int n = 0; n < 2; ++n) acc[a][b][m][n] = (f32x4){0.f, 0.f, 0.f, 0.f};
    int one8 = 0x7f7f7f7f; OPAQUE_V(one8);
    bf16x8 At[4][2], B0[2][2], B1[2][2]; i32x8 At8[4], B08[2], B18[2];
    unsigned oC0[2], oC1[2], oN0[2], oN1[2];
#pragma unroll
    for (int i = 0; i < 2; ++i) { oC0[i] = S.a_off(cur, sR[i]) + (unsigned)sC[i] * 2u; oC1[i] = S.a_off(cur, HALF + sR[i]) + (unsigned)sC[i] * 2u; }
    const char* cB = (const char*)S.b_tile(cur);
    G_STAGE(G_SB(0, 0), cB, voffB); G_STAGE(G_SB(0, 1), cB + hstep, voffB); G_STAGE(G_SA(0, 0), Abase, oC0); G_STAGE(G_SA(0, 1), Abase, oC1);
    if (wr == 1) G_BAR;
    G_WAIT_V(2); G_BAR;
    G_STAGE(G_SB(1, 0), cB + kstep, voffB); G_STAGE(G_SA(1, 0), Abase + kstep, oC0); G_STAGE(G_SB(1, 1), cB + hstep + kstep, voffB);
    G_WAIT_V(6); G_BAR;
    for (;;) {
        const bool has_next = S.next(ui + 1, nxt);
        const char* nB = cB;
        if (has_next) nB = (const char*)S.b_tile(nxt);
        if constexpr (!Sched::LATE_OFF) {
#pragma unroll
            for (int i = 0; i < 2; ++i) { oN0[i] = oC0[i]; oN1[i] = oC1[i]; }
            if (has_next) {
#pragma unroll
                for (int i = 0; i < 2; ++i) { oN0[i] = S.a_off(nxt, sR[i]) + (unsigned)sC[i] * 2u; oN1[i] = S.a_off(nxt, HALF + sR[i]) + (unsigned)sC[i] * 2u; } }
        }
        for (int t = 0; t < nt; t += 2) {
            const bool last = (t == nt - 2);
            const char* a1 = Abase + (size_t)(t + 1) * kstep;
            const char* a2 = last ? Abase : Abase + (size_t)(t + 2) * kstep; const char* b2 = last ? nB : cB + (size_t)(t + 2) * kstep;
            const char* a3 = a2 + kstep; const char* b3 = b2 + kstep;
            unsigned o20[2], o21[2];
#pragma unroll
            for (int i = 0; i < 2; ++i) { o20[i] = oC0[i]; o21[i] = oC1[i]; }
            if (last) {
                if constexpr (Sched::LATE_OFF) { if (has_next) {
#pragma unroll
                    for (int i = 0; i < 2; ++i) { o20[i] = S.a_off(nxt, sR[i]) + (unsigned)sC[i] * 2u; o21[i] = S.a_off(nxt, HALF + sR[i]) + (unsigned)sC[i] * 2u; } } }
                else {
#pragma unroll
                    for (int i = 0; i < 2; ++i) { o20[i] = oN0[i]; o21[i] = oN1[i]; } } }
            G_LDB(B0, 0, 0); G_LDB(B1, 0, 1); G_SCHED; G_LDA(At, 0, 0); G_STAGE(G_SA(1, 1), a1, oC1);
            G_WAIT_V(8); G_WAIT_L(0); G_BAR; G_MMA(0, 0, At, B0); G_MMA(0, 1, At, B1); G_BAR; G_SCHED;
            G_LDA(At, 0, 1); G_STAGE(G_SB(0, 0), b2, voffB); G_STAGE(G_SB(0, 1), b2 + hstep, voffB); G_STAGE(G_SA(0, 0), a2, o20);
            G_WAIT_V(8); G_WAIT_L(0); G_BAR; G_MMA(1, 0, At, B0); G_MMA(1, 1, At, B1); G_BAR; G_SCHED;
            G_LDB(B0, 1, 0); G_LDB(B1, 1, 1); G_SCHED; G_LDA(At, 1, 0); G_STAGE(G_SA(0, 1), a2, o21);
            G_WAIT_V(8); G_WAIT_L(0); G_BAR; G_MMA(0, 0, At, B0); G_MMA(0, 1, At, B1); G_BAR; G_SCHED;
            G_LDA(At, 1, 1); G_STAGE(G_SB(1, 0), b3, voffB); G_STAGE(G_SB(1, 1), b3 + hstep, voffB); G_STAGE(G_SA(1, 0), a3, o20);
            G_WAIT_V(8); G_WAIT_L(0); G_BAR; G_MMA(1, 0, At, B0); G_MMA(1, 1, At, B1); G_BAR; G_SCHED;
        }
        if (wr == 0) G_BAR;
        if constexpr (FP8) asm volatile("s_nop 15\n\ts_nop 15\n\ts_nop 15" ::: "memory");
        if constexpr (Epi::FUSED) E.fused(acc, cur, wr, wc, fr, fq, lds, wid, lane); else E(acc, cur, wr, wc, fr, fq);
        if (!has_next) break;
#pragma unroll
        for (int a = 0; a < 2; ++a)
#pragma unroll
            for (int b = 0; b < 2; ++b)
#pragma unroll
                for (int m = 0; m < 4; ++m)
#pragma unroll
                    for (int n = 0; n < 2; ++n) acc[a][b][m][n] = (f32x4){0.f, 0.f, 0.f, 0.f};
        cur = nxt; cB = nB; ++ui; cur.seq = ui; E.unit_begin(cur, lds, wid, lane);
#pragma unroll
        for (int i = 0; i < 2; ++i) { if constexpr (Sched::LATE_OFF) { oC0[i] = S.a_off(cur, sR[i]) + (unsigned)sC[i] * 2u; oC1[i] = S.a_off(cur, HALF + sR[i]) + (unsigned)sC[i] * 2u; } else { oC0[i] = oN0[i]; oC1[i] = oN1[i]; } }
        if (wr == 1) G_BAR;
    }
    G_WAIT_V(0);
    G_BAR;
#undef G_SA
#undef G_SB
#undef G_STAGE
#undef G_LDA
#undef G_LDB
#undef G_MMA
#undef G_LD8
#undef G_WAIT_V
#undef G_WAIT_L
#undef G_BAR
#undef G_SCHED
}

#define GEMM(S, E, K) gemm_mfma(lds, S, E, (K) * 2, wave)
#define GEMM8(S, E, K) gemm_mfma<decltype(S), decltype(E), true>(lds, S, E, (K), wave)

typedef float f32x16 __attribute__((ext_vector_type(16)));
typedef short s16x4 __attribute__((ext_vector_type(4)));
constexpr int AT_NS = 4, AT_K = 0, AT_V = AT_NS * 8192, AT_WS = 2 * AT_NS * 8192, AT_OST = AT_WS + 4096;
constexpr float AT_THR = 8.0f;
__device__ __forceinline__ int crow(int r, int hi) { return (r & 3) + 8 * (r >> 2) + 4 * hi; }
__device__ __forceinline__ s16x4 vtr(LAS unsigned char* p) { return __builtin_bit_cast(s16x4, __builtin_amdgcn_ds_read_tr16_b64_v4i16((LAS s16x4*)p)); }

__device__ __forceinline__ void attn_unit(LAS unsigned char* lds, int b, int kvh, int qblk, const bf16* Q, const bf16* Kb, const bf16* Vb, bf16* AO, const float* sink, const int wid) {
    const int lane = lane_id(), r32 = lane & 31, hi = lane >> 5;
    const int g = wid >> 1, th = wid & 1, hq = kvh * 4 + g;
    const bf16* Kh = Kb + (size_t)b * KROWS * 128 + kvh * 64; const bf16* Vh = Vb + (size_t)b * KROWS * 128 + kvh * 64;
    const int jlo = (qblk == 0) ? 2 : 0, jhi = (qblk == SEQ / 128 - 1) ? 4 : 6, ntile = (jhi - jlo) + 4;
    const size_t tok0 = (size_t)b * SEQ + qblk * 128 + th * 64;
    bf16x8 qr[2][4];
#pragma unroll
    for (int sb = 0; sb < 2; ++sb)
#pragma unroll
        for (int d0 = 0; d0 < 4; ++d0) qr[sb][d0] = *(const bf16x8*)(Q + (tok0 + sb * 32 + r32) * 512 + hq * 64 + d0 * 16 + hi * 8);
    float mhat[2], lreg[2]; f32x16 o[2][2];
#pragma unroll
    for (int sb = 0; sb < 2; ++sb) { mhat[sb] = sink[hq] * LOG2E; lreg[sb] = (hi == 0) ? 1.0f : 0.0f;
#pragma unroll
        for (int d0 = 0; d0 < 2; ++d0)
#pragma unroll
            for (int r = 0; r < 16; ++r) o[sb][d0][r] = 0.f; }
    LAS float* wsf = (LAS float*)(lds + AT_WS + wid * 256);
#define AT_ROWBASE(jj) (((jlo + (jj)) < jhi) ? (CTX + (qblk - 1) * 128 + 64 * (jlo + (jj))) : (64 * (jlo + (jj) - jhi)))
#define AT_DMA(jj, slot) do { int l_ = lane; OPAQUE_V(l_); const size_t rb_ = (size_t)AT_ROWBASE(jj) * 128; \
        __builtin_amdgcn_global_load_lds((const unsigned*)(Kh + rb_ + (size_t)l_ * 128 + wid * 8), (LAS unsigned*)(lds + AT_K + (slot) * 8192 + wid * 1024), 16, 0, 0); \
        __builtin_amdgcn_global_load_lds((const unsigned*)(Vh + rb_ + (size_t)(16 * (wid & 3) + (l_ >> 2)) * 128 + (wid >> 2) * 32 + (l_ & 3) * 8), (LAS unsigned*)(lds + AT_V + (slot) * 8192 + wid * 1024), 16, 0, 0); } while (0)
    AT_DMA(0, 0); AT_DMA(1, 1); AT_DMA(2, 2);
    for (int jj = 0; jj < ntile; ++jj) {
        const int slot = jj & (AT_NS - 1);
        { const int rem = ntile - 1 - jj;
          if (rem >= 2) asm volatile("s_waitcnt vmcnt(4)" ::: "memory"); else if (rem == 1) asm volatile("s_waitcnt vmcnt(2)" ::: "memory"); else asm volatile("s_waitcnt vmcnt(0)" ::: "memory"); }
        __builtin_amdgcn_s_barrier(); asm volatile("" ::: "memory");
        if (jj + 3 < ntile) AT_DMA(jj + 3, (jj + 3) & (AT_NS - 1));
        const int j = jlo + jj;
        bf16x8 kf[8];
        { LAS unsigned char* kp = lds + AT_K + slot * 8192 + hi * 1024 + r32 * 16;
#pragma unroll
          for (int d0 = 0; d0 < 4; ++d0) { kf[2 * d0] = *(const LAS bf16x8*)(kp + d0 * 2048); kf[2 * d0 + 1] = *(const LAS bf16x8*)(kp + d0 * 2048 + 512); } }
        LAS unsigned char* vp = lds + AT_V + slot * 8192 + ((lane >> 4) & 1) * 32 + (lane & 3) * 8 + (4 * hi + ((lane & 15) >> 2)) * 64;
        int lbw = -1000, ubw = 1000;
        if (j < jhi) { if (j == 0) lbw = 0; else if (j == 1) lbw = -64; else if (j == 4) ubw = 0; else if (j == 5) ubw = -64; }
#pragma unroll
        for (int sb = 0; sb < 2; ++sb) {
            __builtin_amdgcn_sched_barrier(0);
            f32x16 p0, p1;
            { const float nm = -mhat[sb];
#pragma unroll
              for (int r = 0; r < 16; ++r) { p0[r] = nm; p1[r] = nm; } }
#pragma unroll
            for (int d0 = 0; d0 < 4; ++d0) { p0 = __builtin_amdgcn_mfma_f32_32x32x16_bf16(kf[2 * d0], qr[sb][d0], p0, 0, 0, 0); p1 = __builtin_amdgcn_mfma_f32_32x32x16_bf16(kf[2 * d0 + 1], qr[sb][d0], p1, 0, 0, 0); }
            if (lbw != -1000 || ubw != 1000) {
                const int qo = th * 64 + sb * 32 + r32; const int lb = (lbw == -1000) ? -1000 : lbw + qo, ub = (ubw == 1000) ? 1000 : ubw + qo;
#pragma unroll
                for (int r = 0; r < 16; ++r) { const int kv = crow(r, hi); if (kv < lb || kv > ub) p0[r] = -1.0e30f; if (kv + 32 < lb || kv + 32 > ub) p1[r] = -1.0e30f; }
            }
            float mx = fmaxf(p0[0], p1[0]);
#pragma unroll
            for (int r = 1; r < 16; ++r) mx = fmaxf(mx, fmaxf(p0[r], p1[r]));
            mx = fmaxf(mx, __shfl_xor(mx, 32));
            if (__builtin_expect(__any(mx > AT_THR), 0)) {
                const float dl = fmaxf(mx, 0.f), f = __builtin_amdgcn_exp2f(-dl); mhat[sb] += dl;
#pragma unroll
                for (int r = 0; r < 16; ++r) { p0[r] -= dl; p1[r] -= dl; }
                lreg[sb] *= f;
                if (hi == 0) wsf[r32] = f;
                asm volatile("s_waitcnt lgkmcnt(0)" ::: "memory");
#pragma unroll
                for (int r = 0; r < 16; ++r) { const float fr_ = wsf[crow(r, hi)]; o[sb][0][r] *= fr_; o[sb][1][r] *= fr_; }
                asm volatile("s_waitcnt lgkmcnt(0)" ::: "memory");
            }
            float ps = 0.f;
#pragma unroll
            for (int r = 0; r < 16; ++r) { p0[r] = __builtin_amdgcn_exp2f(p0[r]); p1[r] = __builtin_amdgcn_exp2f(p1[r]); ps += p0[r] + p1[r]; }
            lreg[sb] += ps;
            u32x4 pw[4];
#pragma unroll
            for (int q = 0; q < 4; ++q) { pw[0][q] = pk2(p0[2 * q], p0[2 * q + 1]); pw[1][q] = pk2(p0[8 + 2 * q], p0[8 + 2 * q + 1]); pw[2][q] = pk2(p1[2 * q], p1[2 * q + 1]); pw[3][q] = pk2(p1[8 + 2 * q], p1[8 + 2 * q + 1]); }
#pragma unroll
            for (int d0 = 0; d0 < 2; ++d0) {
                s16x4 lo[4], hh[4]; const unsigned vb = (unsigned)(uintptr_t)vp;
#pragma unroll
                for (int ks = 0; ks < 4; ++ks) {
                    asm volatile("ds_read_b64_tr_b16 %0, %1 offset:%c2" : "=&v"(lo[ks]) : "v"(vb), "i"(d0 * 4096 + ks * 1024) : "memory");
                    asm volatile("ds_read_b64_tr_b16 %0, %1 offset:%c2" : "=&v"(hh[ks]) : "v"(vb), "i"(d0 * 4096 + ks * 1024 + 512) : "memory"); }
                asm volatile("s_waitcnt lgkmcnt(0)" ::: "memory"); __builtin_amdgcn_sched_barrier(0);
#pragma unroll
                for (int ks = 0; ks < 4; ++ks) { const bf16x8 vf = (bf16x8){lo[ks][0], lo[ks][1], lo[ks][2], lo[ks][3], hh[ks][0], hh[ks][1], hh[ks][2], hh[ks][3]};
                    o[sb][d0] = __builtin_amdgcn_mfma_f32_32x32x16_bf16(__builtin_bit_cast(bf16x8, pw[ks]), vf, o[sb][d0], 0, 0, 0); }
            }
        }
        asm volatile("s_waitcnt lgkmcnt(0)" ::: "memory");
    }
#pragma unroll
    for (int sb = 0; sb < 2; ++sb) {
        const float l = lreg[sb] + __shfl_xor(lreg[sb], 32);
        if (hi == 0) wsf[r32] = 1.0f / l;
        asm volatile("s_waitcnt lgkmcnt(0)" ::: "memory");
        LAS bf16* stg = (LAS bf16*)(lds + AT_OST + wid * 4096);
#pragma unroll
        for (int r = 0; r < 16; ++r) { const int row = crow(r, hi); const float rl = wsf[row];
            stg[row * 64 + r32] = (bf16)(pk2(o[sb][0][r] * rl, 0.f) & 0xffffu); stg[row * 64 + 32 + r32] = (bf16)(pk2(o[sb][1][r] * rl, 0.f) & 0xffffu); }
        asm volatile("s_waitcnt lgkmcnt(0)" ::: "memory");
        bf16* op = AO + (tok0 + sb * 32 + (lane >> 3)) * 512 + hq * 64 + (lane & 7) * 8;
#pragma unroll
        for (int i = 0; i < 4; ++i) { const u32x4 v = *(const LAS u32x4*)(stg + (i * 8 + (lane >> 3)) * 64 + (lane & 7) * 8); *(u32x4*)(op + (size_t)i * 8 * 512) = v; }
        asm volatile("s_waitcnt lgkmcnt(0)" ::: "memory");
    }
    __syncthreads();
#undef AT_ROWBASE
#undef AT_DMA
}

#define XB_TMO      128
#define XB_XCNT(j)  (256  + 64 * (j))
#define XB_XSUB(j)  (1280 + 64 * (j))
#define XB_XGEN(j)  (2304 + 64 * (j))
#define XB_TOP      3328
#define XB_TOPGEN   3392
#define XCD_BAR_WORDS 3456
#define XB_SPIN_CAP (1u << 18)

__device__ __forceinline__ unsigned xb_ld(unsigned* p)              { return __hip_atomic_load(p, __ATOMIC_RELAXED, __HIP_MEMORY_SCOPE_AGENT); }
__device__ __forceinline__ unsigned xb_add(unsigned* p, unsigned v) { return __hip_atomic_fetch_add(p, v, __ATOMIC_RELAXED, __HIP_MEMORY_SCOPE_AGENT); }
__device__ __forceinline__ unsigned xb_xcc_id() { return (unsigned)__builtin_amdgcn_s_getreg((3 << 11) | 20) & 0xFu; }
#define XB_SPIN(cond, bar) do { unsigned _sp = 0; while (cond) { __builtin_amdgcn_s_sleep(1); \
    if ((++_sp & 255u) == 0u) { if (xb_ld(&(bar)[XB_TMO])) break; if (_sp > XB_SPIN_CAP) { atomicAdd(&(bar)[XB_TMO], 1u); break; } } } } while (0)

struct XcdBarrier {
    unsigned* bar; unsigned x;
    volatile LAS unsigned* st;
};

__device__ __forceinline__ XcdBarrier xcd_barrier_post(unsigned* bar, volatile LAS unsigned* st) {
    XcdBarrier b; b.bar = bar; b.x = xb_xcc_id(); b.st = st;
    if (threadIdx.x == 0) (void)xb_add(&bar[XB_XCNT(b.x)], 1u);
    return b;
}
__device__ __forceinline__ void xcd_barrier_complete(unsigned* bar, unsigned x, unsigned& nloc, unsigned& nx) {
    const unsigned G = gridDim.x * gridDim.y * gridDim.z;
    unsigned sum, cnt, mine, sp = 0u;
    for (;;) {
        sum = 0u; cnt = 0u; mine = 0u;
#pragma unroll
        for (unsigned j = 0; j < 16; ++j) { const unsigned c = xb_ld(&bar[XB_XCNT(j)]); sum += c; cnt += (c > 0u) ? 1u : 0u; mine = (j == x) ? c : mine; }
        if (sum == G) break;
        __builtin_amdgcn_s_sleep(1);
        if ((++sp & 255u) == 0u) { if (xb_ld(&bar[XB_TMO])) break; if (sp > XB_SPIN_CAP) { atomicAdd(&bar[XB_TMO], 1u); break; } }
    }
    nloc = mine > 0u ? mine : 1u; nx = cnt > 0u ? cnt : 1u;
}

__device__ __forceinline__ void xcd_barrier(const XcdBarrier& b) {
    asm volatile("s_waitcnt vmcnt(0)" ::: "memory");
    __syncthreads();
    if (threadIdx.x == 0) {
        unsigned* bar = b.bar;
        __builtin_amdgcn_s_waitcnt(0);
        unsigned nloc = b.st[0], nx = b.st[1];
        if (nloc == 0u) { xcd_barrier_complete(bar, b.x, nloc, nx); b.st[0] = nloc; b.st[1] = nx; }
        const unsigned old = xb_add(&bar[XB_XSUB(b.x)], 1u);
        const unsigned gen = old / nloc;
        if (old + 1u == (gen + 1u) * nloc) {
            __builtin_amdgcn_fence(__ATOMIC_RELEASE, "agent");
            asm volatile("s_waitcnt vmcnt(0)" ::: "memory");
            const unsigned og = xb_add(&bar[XB_TOP], 1u);
            const unsigned tg = og / nx;
            if (og + 1u == (tg + 1u) * nx) xb_add(&bar[XB_TOPGEN], 1u);
            else XB_SPIN(xb_ld(&bar[XB_TOPGEN]) == tg, bar);
            __builtin_amdgcn_fence(__ATOMIC_ACQUIRE, "agent");
            xb_add(&bar[XB_XGEN(b.x)], 1u);
            asm volatile("s_waitcnt vmcnt(0)" ::: "memory");
        } else {
            XB_SPIN(xb_ld(&bar[XB_XGEN(b.x)]) == gen, bar);
            __builtin_amdgcn_fence(__ATOMIC_ACQUIRE, "agent");
            asm volatile("s_waitcnt vmcnt(0)" ::: "memory");
        }
    }
    __syncthreads();
}


template <int HW> __device__ __forceinline__ void pool_item(const bf16* Ub, bf16* Dp, int t, int g, int c) {
    const int s = t & (SEQ - 1);
    const bf16* base = Ub + (size_t)(t - s) * 512 + g * 128 + c * 8;
    u32x4 v[2 * HW]; int cnt = 0;
#pragma unroll
    for (int i = 0; i < 2 * HW; ++i) { const int j = s - HW + i; const bool ok = (j >= 0) && (j < SEQ); cnt += ok ? 1 : 0; v[i] = *(const u32x4*)(base + (size_t)(ok ? j : s) * 512); if (!ok) v[i] = (u32x4){0u, 0u, 0u, 0u}; }
    float a[8];
#pragma unroll
    for (int q = 0; q < 8; ++q) a[q] = 0.f;
#pragma unroll
    for (int i = 0; i < 2 * HW; ++i) { a[0] += bflo(v[i].x); a[1] += bfhi(v[i].x); a[2] += bflo(v[i].y); a[3] += bfhi(v[i].y); a[4] += bflo(v[i].z); a[5] += bfhi(v[i].z); a[6] += bflo(v[i].w); a[7] += bfhi(v[i].w); }
    const float rc = 1.0f / (float)cnt; const u32x4 sv = v[HW];
    u32x4 w; w.x = pk2(a[0] * rc - bflo(sv.x), a[1] * rc - bfhi(sv.x)); w.y = pk2(a[2] * rc - bflo(sv.y), a[3] * rc - bfhi(sv.y));
    w.z = pk2(a[4] * rc - bflo(sv.z), a[5] * rc - bfhi(sv.z)); w.w = pk2(a[6] * rc - bflo(sv.w), a[7] * rc - bfhi(sv.w));
    *(u32x4*)(Dp + (size_t)t * 512 + g * 128 + c * 8) = w;
}

template <int CTRL> __device__ __forceinline__ unsigned dpp_u(unsigned v) { return (unsigned)__builtin_amdgcn_update_dpp(0, (int)v, CTRL, 0xf, 0xf, true); }
template <int CTRL> __device__ __forceinline__ float dpp_f(float v) { return __uint_as_float(dpp_u<CTRL>(__float_as_uint(v))); }
constexpr int DPP_XOR1 = 0xB1, DPP_XOR2 = 0x4E, DPP_HMIRROR = 0x141, DPP_MIRROR = 0x140;
__device__ __forceinline__ unsigned long long wave_max_u64(unsigned long long v) {
    unsigned hi = (unsigned)(v >> 32), lo = (unsigned)v;
#define WM_STEP(CTRL) { const unsigned ohi = dpp_u<CTRL>(hi), olo = dpp_u<CTRL>(lo); const bool take = (ohi > hi) || (ohi == hi && olo > lo); hi = take ? ohi : hi; lo = take ? olo : lo; }
    WM_STEP(DPP_XOR1) WM_STEP(DPP_XOR2) WM_STEP(DPP_HMIRROR) WM_STEP(DPP_MIRROR)
#undef WM_STEP
    unsigned long long r = 0;
#pragma unroll
    for (int q = 0; q < 4; ++q) { const unsigned long long c = ((unsigned long long)(unsigned)__builtin_amdgcn_readlane((int)hi, 16 * q) << 32) | (unsigned)__builtin_amdgcn_readlane((int)lo, 16 * q); r = c > r ? c : r; }
    return r;
}
template <int CTRL, int ROWMASK> __device__ __forceinline__ unsigned dpp_rm(unsigned v) { return (unsigned)__builtin_amdgcn_update_dpp((int)v, (int)v, CTRL, ROWMASK, 0xf, false); }
constexpr int DPP_BCAST15 = 0x142, DPP_BCAST31 = 0x143;
__device__ __forceinline__ unsigned wave_max_u32(unsigned v) {
    v = max(v, dpp_u<DPP_XOR1>(v)); v = max(v, dpp_u<DPP_XOR2>(v)); v = max(v, dpp_u<DPP_HMIRROR>(v)); v = max(v, dpp_u<DPP_MIRROR>(v));
    v = max(v, dpp_rm<DPP_BCAST15, 0xa>(v)); v = max(v, dpp_rm<DPP_BCAST31, 0xc>(v));
    return (unsigned)__builtin_amdgcn_readlane((int)v, 63);
}
__device__ __forceinline__ unsigned wave_min_u32(unsigned v) {
    v = min(v, dpp_u<DPP_XOR1>(v)); v = min(v, dpp_u<DPP_XOR2>(v)); v = min(v, dpp_u<DPP_HMIRROR>(v)); v = min(v, dpp_u<DPP_MIRROR>(v));
    v = min(v, dpp_rm<DPP_BCAST15, 0xa>(v)); v = min(v, dpp_rm<DPP_BCAST31, 0xc>(v));
    return (unsigned)__builtin_amdgcn_readlane((int)v, 63);
}
__device__ __forceinline__ unsigned f2sortable(float f) { const unsigned u = __float_as_uint(f); return (u & 0x80000000u) ? ~u : (u | 0x80000000u); }

struct TItem { const float* src; bf16* dst; int N, pitch; bool perm; int blk; float q8; };
__device__ __forceinline__ TItem titem_decode(const Params& p, int it, bf16* Win_t, bf16* Wua_t, bf16* Wout_t, bf16* Wr_t, bf16* Wgu_t, bf16* Wd_t) {
    constexpr int I0 = 1664, I1 = 256, I2 = 512, I3 = 128, IE = 384;
    TItem t; t.blk = -1; t.q8 = 0.f; int r = it;
    if (r < I0) { const int kb = r / 104, n0 = (r % 104) * 32; t.src = p.in[7] + (size_t)kb * 64 * IN_DIM + n0; t.N = IN_DIM; t.dst = Win_t + (size_t)n0 * 1024 + kb * 64; t.pitch = 1024; t.perm = n0 >= 768; return t; } r -= I0;
    if (r < I1) { const int kb = r / 32, n0 = (r % 32) * 32; t.src = p.in[11] + (size_t)kb * 64 * 1024 + n0; t.N = 1024; t.dst = Wua_t + (size_t)n0 * 512 + kb * 64; t.pitch = 512; t.perm = true; return t; } r -= I1;
    if (r < I2) { const int kb = r / 32, n0 = (r % 32) * 32; t.src = p.in[13] + (size_t)kb * 64 * 1024 + n0; t.N = 1024; t.dst = Wout_t + (size_t)n0 * 1024 + kb * 64; t.pitch = 1024; t.perm = true; return t; } r -= I2;
    if (r < I3) { const int kb = r / 8, n0 = (r % 8) * 32; t.src = p.in[15] + (size_t)kb * 64 * 256 + n0; t.N = 256; t.dst = Wr_t + (size_t)n0 * 1024 + kb * 64; t.pitch = 1024; t.perm = false; return t; } r -= I3;
    const int e = r / IE, q = r % IE, which = q >> 7, qi = q & 127;
    if (which < 2) {
        const float* W = (e < 256) ? p.in[17 + which] + (size_t)e * 1024 * 256 : p.in[20 + which];
        const int kb = qi / 8, n0 = (qi % 8) * 32; const int rowbase = 256 * (n0 >> 7) + (n0 & 96) + which * 128;
        t.src = W + (size_t)kb * 64 * 256 + n0; t.N = 256; t.dst = (bf16*)((unsigned char*)Wgu_t + (size_t)e * 512 * 1024 + (size_t)rowbase * 1024 + kb * 64); t.pitch = 1024; t.perm = true; t.q8 = WQ8;
    } else {
        const float* W = (e < 256) ? p.in[19] + (size_t)e * 256 * 1024 : p.in[22];
        const int kb = qi / 32, n0 = (qi % 32) * 32;
        t.src = W + (size_t)kb * 64 * 1024 + n0; t.N = 1024; t.dst = (bf16*)((unsigned char*)Wd_t + (size_t)e * 1024 * 256 + (size_t)(n0 & ~255) * 256 + kb * 64); t.pitch = 256; t.perm = true; t.blk = (n0 & 255) >> 5; t.q8 = WDQ8;
    }
    return t;
}
__device__ __forceinline__ void titem_load(const TItem& t, f32x4 (&v)[8], int lane) {
    const float* src = t.src + (size_t)(lane >> 3) * t.N + (lane & 7) * 4;
#pragma unroll
    for (int i = 0; i < 8; ++i) v[i] = __builtin_nontemporal_load((const f32x4*)(src + (size_t)(8 * i) * t.N));
}
__device__ __forceinline__ void titem_finish(const TItem& t, const f32x4 (&v)[8], LAS float* scr, int lane) {
#pragma unroll
    for (int i = 0; i < 8; ++i) { LAS float* d = scr + (8 * i + (lane >> 3)) * 33 + (lane & 7) * 4; d[0] = v[i].x; d[1] = v[i].y; d[2] = v[i].z; d[3] = v[i].w; }
    asm volatile("s_waitcnt lgkmcnt(0)" ::: "memory");
    const int c = lane & 7;
#pragma unroll
    for (int j = 0; j < 4; ++j) { const int n = (lane >> 3) + 8 * j; const LAS float* s = scr + (8 * c) * 33 + n;
        int row = t.perm ? invperm32(n) : n;
        if (t.blk >= 0) row = 128 * ((n >> 3) & 1) + 32 * (t.blk >> 1) + 16 * ((n >> 2) & 1) + 4 * (2 * (t.blk & 1) + (n >> 4)) + (n & 3);
        if (t.q8 != 0.f) { const float q = t.q8; int lo = 0, hi = 0;
            lo = __builtin_amdgcn_cvt_pk_fp8_f32(s[0 * 33] * q, s[1 * 33] * q, lo, false); lo = __builtin_amdgcn_cvt_pk_fp8_f32(s[2 * 33] * q, s[3 * 33] * q, lo, true);
            hi = __builtin_amdgcn_cvt_pk_fp8_f32(s[4 * 33] * q, s[5 * 33] * q, hi, false); hi = __builtin_amdgcn_cvt_pk_fp8_f32(s[6 * 33] * q, s[7 * 33] * q, hi, true);
            *(u32x2*)((unsigned char*)t.dst + (size_t)row * t.pitch + 8 * c) = (u32x2){(unsigned)lo, (unsigned)hi}; }
        else { u32x4 o; o.x = pk2(s[0 * 33], s[1 * 33]); o.y = pk2(s[2 * 33], s[3 * 33]); o.z = pk2(s[4 * 33], s[5 * 33]); o.w = pk2(s[6 * 33], s[7 * 33]);
            *(u32x4*)(t.dst + (size_t)row * t.pitch + 8 * c) = o; } }
    asm volatile("s_waitcnt lgkmcnt(0)" ::: "memory");
}

template <int NR> __device__ __forceinline__ void adaln_rows(const float* xrow, const float* g, const float* sc, const float* sh, bf16* orow, int lane) {
    f32x4 v[NR][4]; float rstd[NR];
#pragma unroll
    for (int r = 0; r < NR; ++r)
#pragma unroll
        for (int j = 0; j < 4; ++j) v[r][j] = __builtin_nontemporal_load((const f32x4*)(xrow + (size_t)r * D) + 64 * j + lane);
#pragma unroll
    for (int r = 0; r < NR; ++r) { float s = 0.f;
#pragma unroll
        for (int j = 0; j < 4; ++j) s += (v[r][j].x * v[r][j].x + v[r][j].y * v[r][j].y) + (v[r][j].z * v[r][j].z + v[r][j].w * v[r][j].w);
        rstd[r] = 1.0f / sqrtf(wave_sum(s) * (1.0f / D) + NORM_EPS); }
#pragma unroll
    for (int j = 0; j < 4; ++j) {
        const int c4 = 64 * j + lane;
        const f32x4 gv = *((const f32x4*)g + c4), scv = *((const f32x4*)sc + c4) + 1.0f, shv = *((const f32x4*)sh + c4);
#pragma unroll
        for (int r = 0; r < NR; ++r) { const f32x4 h = ((v[r][j] * rstd[r]) * gv) * scv + shv; u32x2 w; w.x = pk2(h.x, h.y); w.y = pk2(h.z, h.w); *((u32x2*)(orow + (size_t)r * D) + c4) = w; }
    }
}


constexpr int NIT_ALL = 1664 + 256 + 512 + 128 + 257 * 384;
constexpr int P1_GEMM_WGS = 168, P1_FULL_WGS = 1672 - 9 * P1_GEMM_WGS;
constexpr int BGA_PER_WAVE = 95, BG1_PER_WAVE = 14, BG2_PER_WAVE = 14;
constexpr int BGA_ITEMS = (256 - P1_GEMM_WGS) * 8 * BGA_PER_WAVE, BG1_ITEMS = (P1_GEMM_WGS - P1_FULL_WGS) * 8 * BG1_PER_WAVE, BG2_ITEMS = 128 * 8 * BG2_PER_WAVE;
static_assert(BGA_ITEMS + BG1_ITEMS + BG2_ITEMS <= 257 * 384, "background items are expert items");
#define TRANSPOSE_RANGE(first, stride, end) do { \
        const int lane_t = lane_id(); LAS float* scr_ = (LAS float*)(lds + wave * 8448); \
        int it_ = (first); const int end_ = (end), str_ = (stride); \
        if (it_ < end_) { \
            TItem c0_ = titem_decode(p, it_, Win_t, Wua_t, Wout_t, Wr_t, Wgu_t, Wd_t), c1_ = c0_, c2_ = c0_; \
            f32x4 v0_[8], v1_[8], v2_[8]; titem_load(c0_, v0_, lane_t); \
            if (it_ + str_ < end_) { c1_ = titem_decode(p, it_ + str_, Win_t, Wua_t, Wout_t, Wr_t, Wgu_t, Wd_t); titem_load(c1_, v1_, lane_t); } \
            for (;;) { \
                const int it2_ = it_ + 2 * str_; \
                if (it2_ < end_) { c2_ = titem_decode(p, it2_, Win_t, Wua_t, Wout_t, Wr_t, Wgu_t, Wd_t); titem_load(c2_, v2_, lane_t); } \
                titem_finish(c0_, v0_, scr_, lane_t); \
                it_ += str_; if (it_ >= end_) break; \
                c0_ = c1_; c1_ = c2_; \
                _Pragma("unroll") for (int i_ = 0; i_ < 8; ++i_) { v0_[i_] = v1_[i_]; v1_[i_] = v2_[i_]; } \
            } } } while (0)

constexpr int LDS_BYTES = 147456;
constexpr int LDS_TAB = 131072;

__global__ void __launch_bounds__(512, 2) fwd_kernel(Params p) {
    extern __shared__ __attribute__((aligned(16))) unsigned char lds_raw[];
    LAS unsigned char* lds = (LAS unsigned char*)lds_raw;
    const int wave = __builtin_amdgcn_readfirstlane(threadIdx.x >> 6);
    const int G = gridDim.x, bx = blockIdx.x;
    const int vcu = (G % 8 == 0) ? (bx % 8) * (G / 8) + bx / 8 : bx;
    const int gw = vcu * 8 + wave, NGW = G * 8;
    unsigned char* ws = p.ws;
    int* g_cnt = (int*)(ws + WS_CNT);
    f32x2* g_rope = (f32x2*)(ws + WS_ROPE);
    float* g_mod = (float*)(ws + WS_MOD);
    bf16* Win_t = (bf16*)(ws + WS_WIN); bf16* Wua_t = (bf16*)(ws + WS_WUA); bf16* Weff_t = (bf16*)(ws + WS_WEFF); bf16* Wout_t = (bf16*)(ws + WS_WOUT);
    bf16* Wr_t = (bf16*)(ws + WS_WR); bf16* Wd_t = (bf16*)(ws + WS_WD); bf16* Wgu_t = (bf16*)(ws + WS_WGU);
    bf16* Yb = (bf16*)(ws + WS_Y); bf16* Gt = (bf16*)(ws + WS_G); float* Lg = (float*)(ws + WS_LOGIT); bf16* Hn = (bf16*)(ws + WS_H);
    bf16* Qb = (bf16*)(ws + WS_Q); bf16* AO = (bf16*)(ws + WS_AO); bf16* Ub = (bf16*)(ws + WS_U); bf16* Dp = (bf16*)(ws + WS_DP);
    bf16* Kb = (bf16*)(ws + WS_K); bf16* Vb = (bf16*)(ws + WS_V); bf16* T1 = (bf16*)(ws + WS_T1); bf16* Ysh = (bf16*)(ws + WS_YSH);
    bf16* Hb = (bf16*)(ws + WS_HB); int* ldst = (int*)(ws + WS_LDST); float* lw = (float*)(ws + WS_LW); bf16* H2 = (bf16*)(ws + WS_H2);
    const float* x = p.in[0];

    volatile LAS unsigned* bst = (volatile LAS unsigned*)(lds + LDS_TAB + 4096);
    { const int l0 = lane_id(); if (wave == 0 && l0 < 2) bst[l0] = 0u; }
    __syncthreads();
    XcdBarrier xbar = xcd_barrier_post((unsigned*)(ws + WS_BAR), bst);
#define GRID_BAR() xcd_barrier(xbar)
    {
        const int lane = lane_id(), tid = wave * 64 + lane;
        if (bx == 0 && tid < NE) g_cnt[tid] = 0;
        if (bx == 1) {
            for (int i = tid; i < 1024; i += 512) { const int pos = i >> 4, f = i & 15;
                const float inv = powf(10000.0f, -(float)f / 16.0f); const float ang = (float)pos * inv;
                g_rope[i] = (f32x2){(float)cos((double)ang), (float)sin((double)ang)}; }
        }
        if (bx * 24 < 6144) {
            LAS float* sl = (LAS float*)lds;
            LAS float* red = (LAS float*)(lds + 36864);
            for (int i = tid; i < 9 * 1024; i += 512) { const int r = i >> 10, k = i & 1023; const float cv = (r < 8) ? p.in[1][r * 1024 + k] : p.in[3][k]; sl[i] = cv * sigmoidf_(cv); }
            __syncthreads();
            const int ks = tid >> 3, ct = tid & 7; float a[9][3];
#pragma unroll
            for (int r = 0; r < 9; ++r) { a[r][0] = 0.f; a[r][1] = 0.f; a[r][2] = 0.f; }
            const float* wa = p.in[4] + bx * 24 + 3 * ct;
            for (int kk = 0; kk < 16; ++kk) { const int k = ks * 16 + kk; const float w0 = wa[(size_t)k * 6144], w1 = wa[(size_t)k * 6144 + 1], w2 = wa[(size_t)k * 6144 + 2];
#pragma unroll
                for (int r = 0; r < 9; ++r) { const float s = sl[r * 1024 + k]; a[r][0] += s * w0; a[r][1] += s * w1; a[r][2] += s * w2; } }
#pragma unroll
            for (int r = 0; r < 9; ++r)
#pragma unroll
                for (int c = 0; c < 3; ++c) red[ks * 216 + ct * 27 + r * 3 + c] = a[r][c];
            __syncthreads();
            if (tid < 216) { float s = 0.f; for (int k2 = 0; k2 < 64; ++k2) s += red[k2 * 216 + tid];
                const int ct2 = tid / 27, r = (tid % 27) / 3, c = tid % 3; const int n = bx * 24 + 3 * ct2 + c;
                g_mod[r * 6144 + n] = s + p.in[5][n]; }
            __syncthreads();
        }
        TRANSPOSE_RANGE(gw, NGW, (G == 256 ? NIT_ALL - BGA_ITEMS - BG1_ITEMS - BG2_ITEMS : NIT_ALL));
        {
            const int gt = vcu * 512 + tid;
            if (gt < 131072) {
                const int n = gt & 1023, kg = gt >> 10, g = kg >> 5, c0 = (kg & 31) * 4;
                float a0 = 0.f, a1 = 0.f, a2 = 0.f, a3 = 0.f;
                const float* wp = p.in[9] + (size_t)g * 128 * 128 + (size_t)c0 * 128;
#pragma unroll 16
                for (int d = 0; d < 128; ++d) {
                    const float t = p.in[10][g * 128 + d] * p.in[12][(size_t)(g * 128 + d) * 1024 + n];
                    a0 += wp[d] * t; a1 += wp[128 + d] * t; a2 += wp[256 + d] * t; a3 += wp[384 + d] * t;
                }
                const int row = (n & ~31) + invperm32(n & 31);
                u32x2 w; w.x = pk2(a0, a1); w.y = pk2(a2, a3);
                *(u32x2*)(Weff_t + (size_t)row * 512 + g * 128 + c0) = w;
            }
        }
    }
    GRID_BAR();

    { const int lane = lane_id(); const float* g1n = p.in[6];
      for (int q = gw; q < (T + TC) / 4; q += NGW) { const int m = q * 4;
          if (m < T) { const int b = m >> 12; adaln_rows<4>(x + (size_t)m * D, g1n, g_mod + b * 6144 + 1024, g_mod + b * 6144, Hn + (size_t)m * D, lane); }
          else adaln_rows<4>(p.in[2] + (size_t)(m - T) * D, g1n, g_mod + 8 * 6144 + 1024, g_mod + 8 * 6144, Hn + (size_t)m * D, lane); } }
    GRID_BAR();

    {
        EpiProj E{Qb, Kb, Vb, Ub, Gt, g_rope};
        if (G != 256) { DenseSched S{Hn, Win_t, 2048, 128, 13, G, bx, 8, 128, 2}; GEMM(S, E, 1024); }
        else if (bx < P1_GEMM_WGS) {
            DenseSched S{Hn, Win_t, 2048, 128, 13, P1_GEMM_WGS, bx, 8, 128, 2}; GEMM(S, E, 1024);
            if (bx >= P1_FULL_WGS) { const int w0 = NIT_ALL - BG1_ITEMS - BG2_ITEMS + (bx - P1_FULL_WGS) * 8 + wave; TRANSPOSE_RANGE(w0, (P1_GEMM_WGS - P1_FULL_WGS) * 8, NIT_ALL - BG2_ITEMS); }
        } else { const int w0 = NIT_ALL - BGA_ITEMS - BG1_ITEMS - BG2_ITEMS + (bx - P1_GEMM_WGS) * 8 + wave; TRANSPOSE_RANGE(w0, (256 - P1_GEMM_WGS) * 8, NIT_ALL - BG1_ITEMS - BG2_ITEMS); }
    }
    GRID_BAR();

    {
        for (int uidx = vcu; uidx < NB * 2 * (SEQ / 128); uidx += G) {
            const int qblk = uidx & 31, kvh = (uidx >> 5) & 1, b = uidx >> 6;
            attn_unit(lds, b, kvh, qblk, Qb, Kb, Vb, AO, p.in[8], wave);
        }
        { const int lane = lane_id();
          for (int it = gw; it < T; it += NGW) {
              const int g = it & 3, t = (it >> 2) * 4 + (lane >> 4), c = lane & 15;
              if (g == 0) pool_item<1>(Ub, Dp, t, g, c); else if (g == 1) pool_item<2>(Ub, Dp, t, g, c); else if (g == 2) pool_item<4>(Ub, Dp, t, g, c); else pool_item<8>(Ub, Dp, t, g, c);
          } }
    }
    GRID_BAR();

    { PairSched S{AO, Dp, Wua_t, Weff_t, 1024, 128, 4, G, bx}; EpiGate E{T1, Gt}; GEMM(S, E, 512); }
    GRID_BAR();
    { DenseSched S{T1, Wout_t, 2048, 128, 4, G, bx, 0, 0, 0}; EpiX1F E{x, g_mod, (bf16*)(ws + WS_X1B), H2, p.in[14], (float*)(ws + WS_SLOT), (unsigned*)(ws + WS_PCNT), ws + WS_H2Q}; GEMM(S, E, 1024); }
    GRID_BAR();
    { DenseSched S{H2, Wr_t, 2048, 128, 1, G, bx, 0, 0, 0}; EpiLogit E{Lg}; GEMM(S, E, 1024);
      if (G == 256 && bx >= 128) { const int w0 = NIT_ALL - BG2_ITEMS + (bx - 128) * 8 + wave; TRANSPOSE_RANGE(w0, 1024, NIT_ALL); } }
    GRID_BAR();
    {
        const int lane = lane_id(), tid = wave * 64 + lane;
        LAS int* lhist = (LAS int*)lds; LAS int* gbase = (LAS int*)(lds + 1024); LAS int* sel_e = (LAS int*)(lds + 2048); LAS float* sel_w = (LAS float*)(lds + 6144); LAS int* sel_pos = (LAS int*)(lds + 10240);
        const int tpb = T / G, tpw = tpb / 8, tb0 = vcu * tpb;
        if (tid < 256) lhist[tid] = 0;
        __syncthreads();
        const f32x4 rb = *((const f32x4*)p.in[16] + lane);
        for (int i = 0; i < tpw; i += 2) {
            float sg[2][4], sel[2][4], m1[2], m2[2], gs[2]; unsigned kv[2][4]; int my_e[2]; float my_s[2], ssum[2];
#pragma unroll
            for (int q = 0; q < 2; ++q) { const f32x4 lg = *((const f32x4*)(Lg + (size_t)(tb0 + wave * tpw + i + q) * 256) + lane);
#pragma unroll
                for (int j = 0; j < 4; ++j) { sg[q][j] = sigmoidf_(lg[j]); sel[q][j] = sg[q][j] + rb[j]; }
                m1[q] = fmaxf(sel[q][0], sel[q][1]); m2[q] = fminf(sel[q][0], sel[q][1]);
#pragma unroll
                for (int j = 2; j < 4; ++j) { const float v = sel[q][j]; m2[q] = fmaxf(m2[q], fminf(m1[q], v)); m1[q] = fmaxf(m1[q], v); } }
#define MERGE2(CTRL) { _Pragma("unroll") for (int q = 0; q < 2; ++q) { const float p1 = dpp_f<CTRL>(m1[q]), p2 = dpp_f<CTRL>(m2[q]); const float n1 = fmaxf(m1[q], p1); m2[q] = fmaxf(fminf(m1[q], p1), fmaxf(m2[q], p2)); m1[q] = n1; } }
            MERGE2(DPP_XOR1) MERGE2(DPP_XOR2) MERGE2(DPP_HMIRROR)
#undef MERGE2
            const int g = lane >> 3;
#pragma unroll
            for (int q = 0; q < 2; ++q) { gs[q] = m1[q] + m2[q]; int rank = 0;
#pragma unroll
                for (int g2 = 0; g2 < 8; ++g2) { const float o = __uint_as_float((unsigned)__builtin_amdgcn_readlane((int)__float_as_uint(gs[q]), g2 * 8)); rank += (o > gs[q] || (o == gs[q] && g2 < g)) ? 1 : 0; }
                const bool gsel = rank < 4;
#pragma unroll
                for (int j = 0; j < 4; ++j) kv[q][j] = gsel ? f2sortable(sel[q][j]) : 0u;
                my_e[q] = 0; my_s[q] = 0.f; ssum[q] = 0.f; }
#pragma unroll
            for (int k = 0; k < TOPK; ++k) {
                unsigned wmax[2], ci[2]; int gi[2];
#pragma unroll
                for (int q = 0; q < 2; ++q) wmax[q] = wave_max_u32(max(max(kv[q][0], kv[q][1]), max(kv[q][2], kv[q][3])));
#pragma unroll
                for (int q = 0; q < 2; ++q) { ci[q] = 0xffffu;
#pragma unroll
                    for (int j = 3; j >= 0; --j) ci[q] = (kv[q][j] == wmax[q]) ? (unsigned)(lane * 4 + j) : ci[q]; }
#pragma unroll
                for (int q = 0; q < 2; ++q) gi[q] = (int)wave_min_u32(ci[q]);
#pragma unroll
                for (int q = 0; q < 2; ++q) { const int owner = gi[q] >> 2, oj = gi[q] & 3;
                    const float svl = (oj == 0) ? sg[q][0] : (oj == 1) ? sg[q][1] : (oj == 2) ? sg[q][2] : sg[q][3];
                    const float sv = __uint_as_float((unsigned)__builtin_amdgcn_readlane((int)__float_as_uint(svl), owner));
                    const bool mine = lane == owner;
#pragma unroll
                    for (int j = 0; j < 4; ++j) kv[q][j] = (mine && oj == j) ? 0u : kv[q][j];
                    my_e[q] = (lane == k) ? gi[q] : my_e[q]; my_s[q] = (lane == k) ? sv : my_s[q];
                    ssum[q] += sv; }
            }
            if (lane < TOPK) {
#pragma unroll
                for (int q = 0; q < 2; ++q) { const int tl = wave * tpw + i + q;
                    const int lp = __hip_atomic_fetch_add(&lhist[my_e[q]], 1, __ATOMIC_RELAXED, __HIP_MEMORY_SCOPE_WORKGROUP);
                    sel_e[tl * 8 + lane] = my_e[q]; sel_w[tl * 8 + lane] = my_s[q] / ssum[q] * 2.5f; sel_pos[tl * 8 + lane] = lp; }
            }
        }
        __syncthreads();
        if (tid < 256) { const int c = lhist[tid]; gbase[tid] = c ? atomicAdd(&g_cnt[tid], c) : 0; }
        __syncthreads();
        for (int i = tid; i < tpb * 8; i += 512) { const int e = sel_e[i]; const int pos = gbase[e] + sel_pos[i];
            ldst[(size_t)e * CAP + pos] = (tb0 + (i >> 3)) * 8 + (i & 7); lw[(size_t)e * CAP + pos] = sel_w[i]; }
    }
    GRID_BAR();

    LAS int* tp = (LAS int*)(lds + LDS_TAB); LAS int* lcnt = (LAS int*)(lds + LDS_TAB + 2048);
    {
        const int tid = wave * 64 + lane_id();
        if (tid < 257) lcnt[tid] = (tid < 256) ? __hip_atomic_load(&g_cnt[tid], __ATOMIC_RELAXED, __HIP_MEMORY_SCOPE_AGENT) : T;
        __syncthreads();
        if (tid == 0) { int s = 0; for (int e = 0; e < 257; ++e) { tp[e] = s; s += (lcnt[e] + 255) >> 8; } tp[257] = s; }
        __syncthreads();
    }
    { GroupSched S{tp, lcnt, ws + WS_H2Q, Wgu_t, ldst, 1024, 2, G, vcu, (size_t)512 * 1024, true}; EpiH E{(unsigned char*)Hb, 1.0f / (WQ8 * AQ8)}; GEMM8(S, E, 1024); }
    GRID_BAR();
    { GroupSched S{tp, lcnt, Hb, Wd_t, ldst, 256, 4, G, vcu, (size_t)1024 * 256, false}; EpiY E{(unsigned char*)Yb, (unsigned char*)Ysh, ldst, lw, lcnt, 1.0f / (WDQ8 * HQ8)}; GEMM8(S, E, 256); }
    GRID_BAR();

    {
        const int lane = lane_id(); const unsigned char* Y8 = (const unsigned char*)Yb; const unsigned char* Ysh8 = (const unsigned char*)Ysh;
        for (int t = gw; t < T; t += NGW) {
            const int b = t >> 12; float* xr = p.out + (size_t)t * D + lane * 16; const bf16* x1r = (const bf16*)(ws + WS_X1B) + (size_t)t * D + lane * 16;
            u32x4 yv[9]; f32x4 xv[4];
#pragma unroll
            for (int k = 0; k < 8; ++k) yv[k] = __builtin_nontemporal_load((const u32x4*)(Y8 + ((size_t)t * 8 + k) * 1024) + lane);
            yv[8] = __builtin_nontemporal_load((const u32x4*)(Ysh8 + (size_t)t * 1024) + lane);
            { const u32x4 xa = *((const u32x4*)x1r), xb = *((const u32x4*)x1r + 1);
              xv[0] = (f32x4){bflo(xa.x), bfhi(xa.x), bflo(xa.y), bfhi(xa.y)}; xv[1] = (f32x4){bflo(xa.z), bfhi(xa.z), bflo(xa.w), bfhi(xa.w)};
              xv[2] = (f32x4){bflo(xb.x), bfhi(xb.x), bflo(xb.y), bfhi(xb.y)}; xv[3] = (f32x4){bflo(xb.z), bfhi(xb.z), bflo(xb.w), bfhi(xb.w)}; }
            float f[16];
#pragma unroll
            for (int i = 0; i < 16; ++i) f[i] = 0.f;
#pragma unroll
            for (int k = 0; k < 9; ++k)
#pragma unroll
                for (int q = 0; q < 4; ++q) { const f32x2 lo = __builtin_amdgcn_cvt_pk_f32_fp8((int)yv[k][q], false), hi = __builtin_amdgcn_cvt_pk_f32_fp8((int)yv[k][q], true);
                    f[4 * q] += lo.x; f[4 * q + 1] += lo.y; f[4 * q + 2] += hi.x; f[4 * q + 3] += hi.y; }
            const float* g2p = g_mod + b * 6144 + 5120 + lane * 16; float s = 0.f;
#pragma unroll
            for (int q = 0; q < 4; ++q) { const f32x4 g2 = *((const f32x4*)g2p + q) * (1.0f / YSCALE);
                xv[q] = xv[q] + g2 * (f32x4){f[4 * q], f[4 * q + 1], f[4 * q + 2], f[4 * q + 3]};
                s += (xv[q].x * xv[q].x + xv[q].y * xv[q].y) + (xv[q].z * xv[q].z + xv[q].w * xv[q].w); }
            const float rstd = 1.0f / sqrtf(wave_sum(s) * (1.0f / D) + NORM_EPS);
#pragma unroll
            for (int q = 0; q < 4; ++q) { const f32x4 fg = *((const f32x4*)(p.in[23] + lane * 16) + q); *((f32x4*)xr + q) = (xv[q] * rstd) * fg; }
        }
    }
}

extern "C" void kernel_launch(void* const* d_in, const int* in_sizes, int n_in, void* d_out, int out_size, void* d_ws, size_t ws_size, hipStream_t stream) {
    static int grid = 0;
    if (grid == 0) {
        if (n_in != 24 || ws_size < WS_END) { fprintf(stderr, "kernel_launch: unexpected n_in %d or ws_size %zu (need %zu)\n", n_in, ws_size, (size_t)WS_END); grid = -1; return; }
        int dev = 0, cus = 0, per_cu = 0;
        (void)hipGetDevice(&dev); (void)hipDeviceGetAttribute(&cus, hipDeviceAttributeMultiprocessorCount, dev);
        (void)hipFuncSetAttribute((const void*)fwd_kernel, hipFuncAttributeMaxDynamicSharedMemorySize, LDS_BYTES);
        (void)hipOccupancyMaxActiveBlocksPerMultiprocessor(&per_cu, (const void*)fwd_kernel, 512, LDS_BYTES);
        if (per_cu < 1) { fprintf(stderr, "kernel_launch: occupancy query says %d blocks per CU\n", per_cu); per_cu = 1; }
        (void)hipGetLastError();
        grid = cus;
    }
    if (grid < 0) return;
    (void)hipMemsetAsync((char*)d_ws + WS_BAR, 0, WS_BAR_BYTES, stream);
    Params p{};
    for (int i = 0; i < 24; ++i) p.in[i] = (const float*)d_in[i];
    p.out = (float*)d_out; p.ws = (unsigned char*)d_ws;
    void* args[] = {&p};
    hipError_t e = hipLaunchCooperativeKernel((const void*)fwd_kernel, dim3(grid), dim3(512), args, LDS_BYTES, stream);
    if (e != hipSuccess) fprintf(stderr, "cooperative launch failed: %s (grid %d)\n", hipGetErrorString(e), grid);
}
```

```cpp
#include <hip/hip_runtime.h>
#include <cstdio>
#include <cstdint>


constexpr int D = 1024, NB = 8, SEQ = 4096, T = NB * SEQ, CTX = 256, TC = NB * CTX;
constexpr int IN_DIM = 3328, NE = 256, TOPK = 8, FE = 256;
constexpr int KROWS = CTX + SEQ;
constexpr int CAP = T;
constexpr float NORM_EPS = 1e-6f;
constexpr float LOG2E = 1.4426950408889634f;
constexpr float WQ8 = 64.0f, AQ8 = 4.0f;
constexpr float WDQ8 = 32.0f, HQ8 = 8.0f;
constexpr float QSCALE = 0.125f * LOG2E;

constexpr size_t MiB = 1u << 20;
constexpr size_t WS_CNT = 0;
constexpr size_t WS_ROPE = 4096;
constexpr size_t WS_MOD = 16384;
constexpr size_t WS_BAR = 512 * 1024;
constexpr size_t WS_PCNT = WS_BAR + 16384;
constexpr size_t WS_BAR_BYTES = 16384 + 32768;
constexpr size_t WS_SLOT = 1 * MiB;
constexpr size_t WS_WIN = 2 * MiB;
constexpr size_t WS_WUA = 9 * MiB;
constexpr size_t WS_WEFF = 10 * MiB;
constexpr size_t WS_WOUT = 11 * MiB;
constexpr size_t WS_WR = 13 * MiB;
constexpr size_t WS_WD = 14 * MiB;
constexpr size_t WS_WGU = 143 * MiB;
constexpr size_t WS_Y = 143 * MiB;
constexpr size_t WS_G = 400 * MiB;
constexpr size_t WS_LOGIT = 400 * MiB;
constexpr size_t WS_X1B = 464 * MiB;
constexpr size_t WS_H2Q = 432 * MiB;
constexpr size_t WS_H = 528 * MiB;
constexpr size_t WS_Q = 596 * MiB;
constexpr size_t WS_AO = 628 * MiB;
constexpr size_t WS_U = 660 * MiB;
constexpr size_t WS_DP = 692 * MiB;
constexpr size_t WS_K = 724 * MiB;
constexpr size_t WS_V = 733 * MiB;
constexpr size_t WS_T1 = 742 * MiB;
constexpr size_t WS_YSH = 655 * MiB;
constexpr size_t WS_HB = 719 * MiB;
constexpr size_t WS_LDST = 895 * MiB;
constexpr size_t WS_LW = 927 * MiB;
constexpr size_t WS_H2 = 959 * MiB;
constexpr size_t WS_END = 1023 * MiB;

#define LAS __attribute__((address_space(3)))
typedef unsigned short bf16;
typedef short bf16x8 __attribute__((ext_vector_type(8)));
typedef float f32x4 __attribute__((ext_vector_type(4)));
typedef float f32x2 __attribute__((ext_vector_type(2)));
typedef unsigned u32x4 __attribute__((ext_vector_type(4)));
typedef unsigned u32x2 __attribute__((ext_vector_type(2)));
typedef __bf16 bf16x2_t __attribute__((ext_vector_type(2)));

__device__ __forceinline__ unsigned pk2(float lo, float hi) { f32x2 v = {lo, hi}; bf16x2_t b = __builtin_convertvector(v, bf16x2_t); return __builtin_bit_cast(unsigned, b); }
__device__ __forceinline__ float bflo(unsigned u) { return __uint_as_float(u << 16); }
__device__ __forceinline__ float bfhi(unsigned u) { return __uint_as_float(u & 0xffff0000u); }
__device__ __forceinline__ float bf2f(bf16 h) { return __uint_as_float((unsigned)h << 16); }
__device__ __forceinline__ float sigmoidf_(float x) { return __builtin_amdgcn_rcpf(1.0f + __builtin_amdgcn_exp2f(x * -LOG2E)); }
__device__ __forceinline__ float wave_sum(float v) {
#pragma unroll
    for (int o = 1; o < 64; o <<= 1) v += __shfl_xor(v, o);
    return v;
}
__host__ __device__ __forceinline__ int invperm32(int c) { return 16 * ((c >> 2) & 1) + 4 * (c >> 3) + (c & 3); }

#define OPAQUE_V(x) asm volatile("" : "+v"(x))
__device__ __forceinline__ int lane_id() { int l = __builtin_amdgcn_mbcnt_hi(~0u, __builtin_amdgcn_mbcnt_lo(~0u, 0u)); OPAQUE_V(l); return l; }
struct Params { const float* in[24]; float* out; unsigned char* ws; };

struct Unit { int pm, pn, e, rt, seq; };

__device__ __forceinline__ void static_unit(int L, int nM, int nN, int& pm, int& pn) {
    const int nwg = nM * nN; int wgid = L;
    { const int q = nwg / 8, r = nwg % 8, xcd = wgid % 8, off = wgid / 8; wgid = (xcd < r ? xcd * (q + 1) : r * (q + 1) + (xcd - r) * q) + off; }
    const int nig = 8 * nN, gid = wgid / nig, fm = gid * 8, gsz = (nM - fm) < 8 ? (nM - fm) : 8;
    pm = fm + ((wgid % nig) % gsz); pn = (wgid % nig) / gsz;
}

struct DenseSched {
    static constexpr bool LATE_OFF = true;
    const void* A; const void* Bt; int KB, nM, nN, G, c; int extra, extra_pm0, extra_pn;
    __device__ __forceinline__ bool next(int i, Unit& u) const {
        const int L = i * G + c; const int nwg = nM * nN;
        if (L >= nwg + extra) return false;
        if (L < nwg) static_unit(L, nM, nN, u.pm, u.pn); else { u.pm = extra_pm0 + (L - nwg); u.pn = extra_pn; }
        u.e = 0; u.rt = 0; return true;
    }
    __device__ __forceinline__ unsigned a_off(const Unit& u, int r) const { return (unsigned)(u.pm * 256 + r) * (unsigned)KB; }
    __device__ __forceinline__ const char* b_tile(const Unit& u) const { return (const char*)Bt + (size_t)u.pn * 256 * KB; }
};

struct PairSched {
    static constexpr bool LATE_OFF = true;
    const void* A; const void* A1; const void* Bt; const void* Bt1; int KB, nM, nN, G, c;
    __device__ __forceinline__ bool next(int i, Unit& u) const {
        const int nwg = nM * nN, per = (nwg - c + G - 1) / G;
        if (i >= 2 * per) return false;
        const int mode = i >= per, L = (mode ? i - per : i) * G + c;
        static_unit(L, nM, nN, u.pm, u.pn); u.e = mode; u.rt = 0; return true;
    }
    __device__ __forceinline__ unsigned a_off(const Unit& u, int r) const { return (unsigned)((u.e ? (const char*)A1 - (const char*)A : 0) + (size_t)(u.pm * 256 + r) * KB); }
    __device__ __forceinline__ const char* b_tile(const Unit& u) const { return (const char*)(u.e ? Bt1 : Bt) + (size_t)u.pn * 256 * KB; }
};

typedef int i32x4_t __attribute__((ext_vector_type(4)));
struct GroupSched {
    static constexpr bool LATE_OFF = false;
    const LAS int* tp; const LAS int* cnt;
    const void* A; const void* Bt; const int* ldst;
    int KB, npn, G, vcu; size_t bstride; bool gather;
    static constexpr int UT = 131072 + 4608;
    __device__ __forceinline__ bool search(int i, Unit& u) const {
        const int L = i * G + vcu; const int total = tp[257] * npn;
        if (L >= total) return false;
        int lo = 0, hi = 257;
        while (hi - lo > 1) { const int mid = (lo + hi) >> 1; if (npn * tp[mid] <= L) lo = mid; else hi = mid; }
        const int e = lo, nt = tp[e + 1] - tp[e], r = L - npn * tp[e];
        u.e = e; u.pn = r / nt; u.rt = r % nt; u.pm = tp[e] + u.rt; return true;
    }
    __device__ __forceinline__ void prepare(LAS unsigned char* lds, int tid) const {
        if (tid < 32) { Unit u; u.e = u.pn = u.rt = u.pm = 0; const bool ok = search(tid, u); *(LAS i32x4_t*)(lds + UT + tid * 16) = (i32x4_t){ok ? u.e : -1, u.pn, u.rt, u.pm}; }
        __syncthreads();
    }
    const LAS unsigned char* ldsb;
    __device__ __forceinline__ bool next(int i, Unit& u) const {
        if (i >= 32) return false;
        const i32x4_t r = *(const LAS i32x4_t*)(ldsb + UT + i * 16);
        const int e = __builtin_amdgcn_readfirstlane(r[0]);
        if (e < 0) return false;
        u.e = e; u.pn = __builtin_amdgcn_readfirstlane(r[1]); u.rt = __builtin_amdgcn_readfirstlane(r[2]); u.pm = __builtin_amdgcn_readfirstlane(r[3]); return true;
    }
    __device__ __forceinline__ unsigned a_off(const Unit& u, int r) const {
        if (!gather) return (unsigned)(u.pm * 256 + r) * (unsigned)KB;
        const int idx = u.rt * 256 + r; int tok;
        if (u.e == 256) tok = idx; else tok = (idx < cnt[u.e]) ? (ldst[(size_t)u.e * CAP + idx] >> 3) : 0;
        return (unsigned)tok * (unsigned)KB;
    }
    __device__ __forceinline__ const char* b_tile(const Unit& u) const { return (const char*)Bt + (size_t)u.e * bstride + (size_t)u.pn * 256 * KB; }
};

constexpr int LDS_TAB_OFF = 131072;
typedef f32x4 Acc[2][2][4][2];

struct EpiProj {
    static constexpr bool FUSED = false;
    __device__ __forceinline__ void unit_begin(const Unit&, LAS unsigned char*, int, int) const {}
    bf16 *Q, *Kb, *Vb, *U, *Gt; const f32x2* rope;
    __device__ __forceinline__ void operator()(const Acc& acc, const Unit& u, int wr, int wc, int fr, int fq) const {
        const int pn = u.pn; const int row0 = u.pm * 256 + wr * 64 + fr;
        if (pn <= 2) {
            const bool isx = row0 < T;
            f32x2 cs[2][4][4];
            if (isx) {
#pragma unroll
                for (int ai = 0; ai < 2; ++ai)
#pragma unroll
                    for (int m = 0; m < 4; ++m) { const int s_ = (row0 + ai * 128 + m * 16) & (SEQ - 1); const int pos = (wc & 1) ? (s_ & 63) : (s_ >> 6);
#pragma unroll
                        for (int j = 0; j < 4; ++j) cs[ai][m][j] = rope[pos * 16 + 4 * fq + j]; }
            }
#pragma unroll
            for (int ai = 0; ai < 2; ++ai)
#pragma unroll
                for (int m = 0; m < 4; ++m) {
                    const int rg = row0 + ai * 128 + m * 16; const int s_ = rg & (SEQ - 1);
#pragma unroll
                    for (int bj = 0; bj < 2; ++bj) {
                        f32x4 a = acc[ai][bj][m][0], b = acc[ai][bj][m][1];
                        const bool isv = (pn == 2 && bj == 1);
                        if (!isv && isx) {
#pragma unroll
                            for (int j = 0; j < 4; ++j) { const f32x2 c = cs[ai][m][j]; const float a0 = a[j], b0 = b[j]; a[j] = a0 * c.x - b0 * c.y; b[j] = b0 * c.x + a0 * c.y; }
                        }
                        bf16* dst;
                        if (pn < 2) { a = a * QSCALE; b = b * QSCALE; dst = Q + (size_t)rg * 512 + pn * 256 + bj * 128 + wc * 32 + 4 * fq; }
                        else {
                            size_t krow; if (isx) krow = (size_t)(rg >> 12) * KROWS + CTX + s_; else { const int j2 = rg - T; krow = (size_t)(j2 >> 8) * KROWS + (j2 & 255); }
                            dst = (bj == 0 ? Kb : Vb) + krow * 128 + wc * 32 + 4 * fq;
                        }
                        u32x2 w0, w1; w0.x = pk2(a[0], a[1]); w0.y = pk2(a[2], a[3]); w1.x = pk2(b[0], b[1]); w1.y = pk2(b[2], b[3]);
                        *(u32x2*)dst = w0; *(u32x2*)(dst + 16) = w1;
                    }
                }
        } else if (pn < 5) {
#pragma unroll
            for (int ai = 0; ai < 2; ++ai)
#pragma unroll
                for (int m = 0; m < 4; ++m) { const size_t rg = (size_t)(row0 + ai * 128 + m * 16);
#pragma unroll
                    for (int bj = 0; bj < 2; ++bj) { const f32x4 a = acc[ai][bj][m][0], b = acc[ai][bj][m][1];
                        u32x4 w; w.x = pk2(a[0], a[1]); w.y = pk2(a[2], a[3]); w.z = pk2(b[0], b[1]); w.w = pk2(b[2], b[3]);
                        *(u32x4*)(U + rg * 512 + (pn - 3) * 256 + bj * 128 + wc * 32 + 8 * fq) = w; } }
        } else {
#pragma unroll
            for (int ai = 0; ai < 2; ++ai)
#pragma unroll
                for (int m = 0; m < 4; ++m) { const size_t rg = (size_t)(row0 + ai * 128 + m * 16);
#pragma unroll
                    for (int bj = 0; bj < 2; ++bj) { const f32x4 a = acc[ai][bj][m][0], b = acc[ai][bj][m][1];
                        u32x4 w; w.x = pk2(a[0], a[1]); w.y = pk2(a[2], a[3]); w.z = pk2(b[0], b[1]); w.w = pk2(b[2], b[3]);
                        *(u32x4*)(Gt + rg * 2048 + (pn - 5) * 256 + bj * 128 + wc * 32 + 8 * fq) = w; } }
        }
    }
};

struct EpiGate {
    static constexpr bool FUSED = false;
    __device__ __forceinline__ void unit_begin(const Unit&, LAS unsigned char*, int, int) const {}
    bf16* T1; const bf16* Gt;
    __device__ __forceinline__ void operator()(const Acc& acc, const Unit& u, int wr, int wc, int fr, int fq) const {
        const int col0 = u.pn * 256 + wc * 32 + 8 * fq; const int mode = u.e;
#pragma unroll
        for (int ai = 0; ai < 2; ++ai)
#pragma unroll
            for (int mh = 0; mh < 2; ++mh) {
                u32x4 g[2][2], t[2][2];
#pragma unroll
                for (int m2 = 0; m2 < 2; ++m2) { const size_t rg = (size_t)(u.pm * 256 + ai * 128 + wr * 64 + (mh * 2 + m2) * 16 + fr);
#pragma unroll
                    for (int bj = 0; bj < 2; ++bj) { g[m2][bj] = *(const u32x4*)(Gt + rg * 2048 + mode * 1024 + col0 + bj * 128); t[m2][bj] = (u32x4){0u, 0u, 0u, 0u}; if (mode) t[m2][bj] = *(const u32x4*)(T1 + rg * 1024 + col0 + bj * 128); } }
#pragma unroll
                for (int m2 = 0; m2 < 2; ++m2) { const int m = mh * 2 + m2; const size_t rg = (size_t)(u.pm * 256 + ai * 128 + wr * 64 + m * 16 + fr);
#pragma unroll
                    for (int bj = 0; bj < 2; ++bj) {
                        const f32x4 a = acc[ai][bj][m][0], b = acc[ai][bj][m][1]; const u32x4 gg = g[m2][bj], tt = t[m2][bj];
                        float v[8] = {a[0] * sigmoidf_(bflo(gg.x)), a[1] * sigmoidf_(bfhi(gg.x)), a[2] * sigmoidf_(bflo(gg.y)), a[3] * sigmoidf_(bfhi(gg.y)), b[0] * sigmoidf_(bflo(gg.z)), b[1] * sigmoidf_(bfhi(gg.z)), b[2] * sigmoidf_(bflo(gg.w)), b[3] * sigmoidf_(bfhi(gg.w))};
                        v[0] += bflo(tt.x); v[1] += bfhi(tt.x); v[2] += bflo(tt.y); v[3] += bfhi(tt.y); v[4] += bflo(tt.z); v[5] += bfhi(tt.z); v[6] += bflo(tt.w); v[7] += bfhi(tt.w);
                        u32x4 w; w.x = pk2(v[0], v[1]); w.y = pk2(v[2], v[3]); w.z = pk2(v[4], v[5]); w.w = pk2(v[6], v[7]);
                        *(u32x4*)(T1 + rg * 1024 + col0 + bj * 128) = w;
                    } }
                asm volatile("" ::: "memory");
            }
    }
};

struct EpiX1F {
    static constexpr bool FUSED = true;
    __device__ __forceinline__ void unit_begin(const Unit&, LAS unsigned char*, int, int) const {}
    const float* x; const float* mod; bf16* x1; bf16* H2; const float* g2n; float* slot; unsigned* pcnt; unsigned char* H2q;
    __device__ __forceinline__ void fused(Acc& acc, const Unit& u, int wr, int wc, int fr_, int fq_, LAS unsigned char* lds, int wid, int lane_) const {
        const int lane1 = lane_id(), fr = lane1 & 15, fq = lane1 >> 4;
        LAS float* P = (LAS float*)(lds + LDS_TAB_OFF + 8192);
        LAS float* S = (LAS float*)(lds + LDS_TAB_OFF + 12288);
        LAS unsigned* flag = (LAS unsigned*)(lds + LDS_TAB_OFF + 13312);
        const int col0 = u.pn * 256 + wc * 32 + 8 * fq; const int b = (u.pm * 256) >> 12; const float* mb = mod + b * 6144;
        { f32x4 g[2][2];
#pragma unroll
          for (int bj = 0; bj < 2; ++bj)
#pragma unroll
              for (int n = 0; n < 2; ++n) g[bj][n] = *(const f32x4*)(mb + 2048 + col0 + bj * 128 + n * 4);
#pragma unroll
          for (int ai = 0; ai < 2; ++ai) {
              f32x4 xv[4][2][2];
#pragma unroll
              for (int m = 0; m < 4; ++m) { const float* xp = x + (size_t)(u.pm * 256 + ai * 128 + wr * 64 + m * 16 + fr) * D + col0;
#pragma unroll
                  for (int bj = 0; bj < 2; ++bj)
#pragma unroll
                      for (int n = 0; n < 2; ++n) xv[m][bj][n] = *(const f32x4*)(xp + bj * 128 + n * 4); }
#pragma unroll
              for (int m = 0; m < 4; ++m) {
#pragma unroll
                  for (int bj = 0; bj < 2; ++bj)
#pragma unroll
                      for (int n = 0; n < 2; ++n) acc[ai][bj][m][n] = xv[m][bj][n] + g[bj][n] * acc[ai][bj][m][n];
                  asm volatile("" : "+v"(acc[ai][0][m][0]), "+v"(acc[ai][0][m][1]), "+v"(acc[ai][1][m][0]), "+v"(acc[ai][1][m][1]));
              }
              asm volatile("" ::: "memory");
          } }
        { const int l2 = lane_id(), fr = l2 & 15, fq = l2 >> 4;
#pragma unroll
        for (int ai = 0; ai < 2; ++ai)
#pragma unroll
            for (int m = 0; m < 4; ++m) { float q = 0.f;
#pragma unroll
                for (int bj = 0; bj < 2; ++bj)
#pragma unroll
                    for (int n = 0; n < 2; ++n) { const f32x4 v = acc[ai][bj][m][n]; q += (v[0] * v[0] + v[1] * v[1]) + (v[2] * v[2] + v[3] * v[3]); }
                q += __shfl_xor(q, 16); q += __shfl_xor(q, 32);
                if (fq == 0) P[(ai * 128 + wr * 64 + m * 16 + fr) * 4 + wc] = q; } }
        asm volatile("s_waitcnt lgkmcnt(0)" ::: "memory"); __builtin_amdgcn_s_barrier(); asm volatile("" ::: "memory");
        const int lane = lane_id(); const int row = wid * 32 + (lane & 31);
        if (lane < 32) { const float t = (P[row * 4 + 0] + P[row * 4 + 1]) + (P[row * 4 + 2] + P[row * 4 + 3]);
            __hip_atomic_store(slot + ((size_t)(u.pm * 256 + row) * 4 + u.pn), t, __ATOMIC_RELAXED, __HIP_MEMORY_SCOPE_AGENT); }
        asm volatile("s_waitcnt vmcnt(0)" ::: "memory");
        if (lane == 0) __hip_atomic_fetch_add(pcnt + 64 * u.pm, 1u, __ATOMIC_RELAXED, __HIP_MEMORY_SCOPE_AGENT);
        if (wid == 0) {
            unsigned spins = 0;
            while ((unsigned)__builtin_amdgcn_readfirstlane(__hip_atomic_load(pcnt + 64 * u.pm, __ATOMIC_RELAXED, __HIP_MEMORY_SCOPE_AGENT)) < 32u) { __builtin_amdgcn_s_sleep(2); if (++spins > (1u << 20)) break; }
            (void)flag; (void)spins;
        }
        asm volatile("s_waitcnt vmcnt(0) lgkmcnt(0)" ::: "memory"); __builtin_amdgcn_s_barrier(); asm volatile("" ::: "memory");
        if (lane < 32) { const float* sl = slot + (size_t)(u.pm * 256 + row) * 4; float t = 0.f;
#pragma unroll
            for (int k = 0; k < 4; ++k) t += __hip_atomic_load(sl + k, __ATOMIC_RELAXED, __HIP_MEMORY_SCOPE_AGENT);
            S[row] = 1.0f / sqrtf(t * (1.0f / D) + NORM_EPS); }
        asm volatile("s_waitcnt lgkmcnt(0)" ::: "memory"); __builtin_amdgcn_s_barrier(); asm volatile("" ::: "memory");
        const int l6 = lane_id(); const int fr6 = l6 & 15; const int c6 = u.pn * 256 + wc * 32 + 8 * (l6 >> 4);
#pragma unroll
        for (int bj = 0; bj < 2; ++bj) {
            f32x4 gs[2], sh[2];
#pragma unroll
            for (int n = 0; n < 2; ++n) { const int c = c6 + bj * 128 + n * 4; gs[n] = *(const f32x4*)(g2n + c) * (*(const f32x4*)(mb + 4096 + c) + 1.0f); sh[n] = *(const f32x4*)(mb + 3072 + c); }
#pragma unroll
            for (int ai = 0; ai < 2; ++ai) {
#pragma unroll
                for (int m = 0; m < 4; ++m) { const int r = ai * 128 + wr * 64 + m * 16 + fr6; const size_t rg = (size_t)(u.pm * 256 + r); const float rstd = S[r];
                    const f32x4 v0 = acc[ai][bj][m][0], v1 = acc[ai][bj][m][1];
                    { u32x4 xw; xw.x = pk2(v0[0], v0[1]); xw.y = pk2(v0[2], v0[3]); xw.z = pk2(v1[0], v1[1]); xw.w = pk2(v1[2], v1[3]); *(u32x4*)(x1 + rg * D + c6 + bj * 128) = xw; }
                    const f32x4 h0 = (v0 * rstd) * gs[0] + sh[0], h1 = (v1 * rstd) * gs[1] + sh[1];
                    u32x4 w; w.x = pk2(h0[0], h0[1]); w.y = pk2(h0[2], h0[3]); w.z = pk2(h1[0], h1[1]); w.w = pk2(h1[2], h1[3]);
                    *(u32x4*)(H2 + rg * D + c6 + bj * 128) = w;
                    { f32x4 q0 = h0 * AQ8, q1 = h1 * AQ8;
#pragma unroll
                      for (int j = 0; j < 4; ++j) { q0[j] = fminf(fmaxf(q0[j], -448.0f), 448.0f); q1[j] = fminf(fmaxf(q1[j], -448.0f), 448.0f); }
                      int lo = 0, hi = 0; lo = __builtin_amdgcn_cvt_pk_fp8_f32(q0[0], q0[1], lo, false); lo = __builtin_amdgcn_cvt_pk_fp8_f32(q0[2], q0[3], lo, true);
                      hi = __builtin_amdgcn_cvt_pk_fp8_f32(q1[0], q1[1], hi, false); hi = __builtin_amdgcn_cvt_pk_fp8_f32(q1[2], q1[3], hi, true);
                      *(u32x2*)(H2q + rg * D + c6 + bj * 128) = (u32x2){(unsigned)lo, (unsigned)hi}; } }
                asm volatile("" ::: "memory");
            }
        }
    }
};

struct EpiLogit {
    static constexpr bool FUSED = false;
    __device__ __forceinline__ void unit_begin(const Unit&, LAS unsigned char*, int, int) const {}
    float* L;
    __device__ __forceinline__ void operator()(const Acc& acc, const Unit& u, int wr, int wc, int fr, int fq) const {
#pragma unroll
        for (int ai = 0; ai < 2; ++ai)
#pragma unroll
            for (int m = 0; m < 4; ++m) {
                const int rg = u.pm * 256 + ai * 128 + wr * 64 + m * 16 + fr;
#pragma unroll
                for (int bj = 0; bj < 2; ++bj)
#pragma unroll
                    for (int n = 0; n < 2; ++n) *(f32x4*)(L + (size_t)rg * 256 + bj * 128 + wc * 32 + n * 16 + 4 * fq) = acc[ai][bj][m][n];

            }
    }
};

struct EpiH {
    static constexpr bool FUSED = false;
    __device__ __forceinline__ void unit_begin(const Unit&, LAS unsigned char*, int, int) const {}
    unsigned char* Hq; float ascale;
    __device__ __forceinline__ void operator()(const Acc& acc, const Unit& u, int wr, int wc, int fr, int fq) const {
#pragma unroll
        for (int ai = 0; ai < 2; ++ai)
#pragma unroll
            for (int m = 0; m < 4; ++m) {
                const int row = u.pm * 256 + ai * 128 + wr * 64 + m * 16 + fr;
                float v[8];
#pragma unroll
                for (int n = 0; n < 2; ++n)
#pragma unroll
                    for (int j = 0; j < 4; ++j) { const float g = acc[ai][0][m][n][j] * ascale, up = acc[ai][1][m][n][j] * ascale; v[4 * n + j] = fminf(fmaxf(g * sigmoidf_(g) * up * HQ8, -448.0f), 448.0f); }
                int lo = 0, hi = 0;
                lo = __builtin_amdgcn_cvt_pk_fp8_f32(v[0], v[1], lo, false); lo = __builtin_amdgcn_cvt_pk_fp8_f32(v[2], v[3], lo, true);
                hi = __builtin_amdgcn_cvt_pk_fp8_f32(v[4], v[5], hi, false); hi = __builtin_amdgcn_cvt_pk_fp8_f32(v[6], v[7], hi, true);
                *(u32x2*)(Hq + (size_t)row * 256 + u.pn * 128 + wc * 32 + 8 * fq) = (u32x2){(unsigned)lo, (unsigned)hi};
            }
    }
};

constexpr float YSCALE = 16.0f;
struct EpiY {
    unsigned char* Y; unsigned char* Ysh; const int* ldst; const float* lw; const LAS int* cnt; float ascale;
    static constexpr bool FUSED = false;
    static constexpr int RI = LDS_TAB_OFF + 8192;
    __device__ __forceinline__ void unit_begin(const Unit& u, LAS unsigned char* lds, int wid, int lane) const {
        if (u.e < 256) {
            const size_t base = (size_t)u.e * CAP + u.rt * 256 + 64 * (wid & 3) + lane;
            LAS unsigned char* d = lds + RI + (u.seq & 1) * 2048 + (wid >> 2) * 1024 + (wid & 3) * 256;
            if (wid < 4) __builtin_amdgcn_global_load_lds((const unsigned*)(ldst + base), (LAS unsigned*)d, 4, 0, 0);
            else __builtin_amdgcn_global_load_lds((const unsigned*)(lw + base), (LAS unsigned*)d, 4, 0, 0);
        }
    }
    __device__ __forceinline__ void operator()(const Acc& acc, const Unit& u, int wr, int wc, int fr, int fq) const {
        const LAS int* rdst = (const LAS int*)((LAS unsigned char*)cnt - 2048 + 8192 + (u.seq & 1) * 2048); const LAS float* rw = (const LAS float*)(rdst + 256);
        const int ce = cnt[u.e];
#pragma unroll
        for (int ai = 0; ai < 2; ++ai)
#pragma unroll
            for (int m = 0; m < 4; ++m) {
                const int r = ai * 128 + wr * 64 + m * 16 + fr, idx = u.rt * 256 + r;
                unsigned char* rowp; float w;
                if (u.e == 256) { rowp = Ysh + (size_t)idx * 1024; w = YSCALE * ascale; }
                else { if (idx >= ce) continue; rowp = Y + (size_t)rdst[r] * 1024; w = rw[r] * (YSCALE * ascale); }
                u32x4 o;
#pragma unroll
                for (int bj = 0; bj < 2; ++bj)
#pragma unroll
                    for (int n = 0; n < 2; ++n) { f32x4 a = acc[ai][bj][m][n] * w;
#pragma unroll
                        for (int j = 0; j < 4; ++j) a[j] = fminf(fmaxf(a[j], -448.0f), 448.0f);
                        int pk = 0; pk = __builtin_amdgcn_cvt_pk_fp8_f32(a[0], a[1], pk, false); pk = __builtin_amdgcn_cvt_pk_fp8_f32(a[2], a[3], pk, true); o[bj * 2 + n] = (unsigned)pk; }
                *(u32x4*)(rowp + u.pn * 256 + wc * 64 + 16 * fq) = o;
            }
    }
};

constexpr int BK = 64, HALF = 128, HTB = HALF * BK * 2;
__device__ __forceinline__ int lds_byte(int r, int c) { const int st = (r >> 4) * 2 + (c >> 5), rr = r & 15, cc = c & 31, ob = rr * 64 + cc * 2; return st * 1024 + (ob ^ (((ob >> 9) & 1) << 5)); }
__device__ __forceinline__ void stage_rc(int b, int& R, int& C) { const int st = b / 1024, sb = b % 1024, swz = sb ^ (((sb >> 9) & 1) << 5); R = (st >> 1) * 16 + swz / 64; C = (st & 1) * 32 + (swz % 64) / 2; }

typedef int i32x8 __attribute__((ext_vector_type(8)));
typedef int i32x4 __attribute__((ext_vector_type(4)));
template <class Sched, class Epi, bool FP8 = false>
__device__ __forceinline__ void gemm_mfma(LAS unsigned char* lds, const Sched& S, const Epi& E, const int KB, const int wid) {
    const int lane = lane_id(), tid = wid * 64 + lane, wr = wid >> 2, wc = wid & 3, fr = lane & 15, fq = lane >> 4;
    const int nt = KB / (BK * 2);
    int sR[2], sC[2]; unsigned voffB[2];
#pragma unroll
    for (int i = 0; i < 2; ++i) { stage_rc(tid * 16 + i * 8192, sR[i], sC[i]); voffB[i] = (unsigned)(sR[i] * KB + sC[i] * 2); }
    const size_t kstep = (size_t)(BK * 2);
    const size_t hstep = (size_t)HALF * KB;
    const unsigned ldsw = (unsigned)wid * 1024u;
    const int aoff = FP8 ? lds_byte(wr * 64 + fr, fq * 16) : lds_byte(wr * 64 + fr, fq * 8), boff = FP8 ? lds_byte(wc * 32 + fr, fq * 16) : lds_byte(wc * 32 + fr, fq * 8);
    const int aoff1 = lds_byte(wr * 64 + fr, fq * 16 + 8), boff1 = lds_byte(wc * 32 + fr, fq * 16 + 8);
    const char* Abase = (const char*)S.A;
#define G_SA(b, h) (((b) * 2 + (h)) * HTB)
#define G_SB(b, h) ((4 + (b) * 2 + (h)) * HTB)
#define G_STAGE(bufoff, gbase, voff) do { _Pragma("unroll") for (int _i = 0; _i < 2; ++_i) \
        __builtin_amdgcn_global_load_lds((const unsigned*)((const char*)(gbase) + (voff)[_i]), (LAS unsigned*)(lds + (bufoff) + ldsw + _i * 8192), 16, 0, 0); } while (0)
#define G_LD8(dst, p0, p1) do { const i32x4 c0_ = *(const LAS i32x4*)(p0), c1_ = *(const LAS i32x4*)(p1); dst = __builtin_shufflevector(c0_, c1_, 0, 1, 2, 3, 4, 5, 6, 7); } while (0)
#define G_LDA(dst, b, h) do { _Pragma("unroll") for (int m = 0; m < 4; ++m) { if constexpr (FP8) G_LD8(dst##8[m], lds + G_SA(b, h) + aoff + m * 2048, lds + G_SA(b, h) + aoff1 + m * 2048); \
        else { _Pragma("unroll") for (int k = 0; k < 2; ++k) dst[m][k] = *(const LAS bf16x8*)(lds + G_SA(b, h) + aoff + m * 2048 + k * 1024); } } } while (0)
#define G_LDB(dst, b, h) do { _Pragma("unroll") for (int n = 0; n < 2; ++n) { if constexpr (FP8) G_LD8(dst##8[n], lds + G_SB(b, h) + boff + n * 2048, lds + G_SB(b, h) + boff1 + n * 2048); \
        else { _Pragma("unroll") for (int k = 0; k < 2; ++k) dst[n][k] = *(const LAS bf16x8*)(lds + G_SB(b, h) + boff + n * 2048 + k * 1024); } } } while (0)
#define G_MMA(ai, bj, At, Bt) do { __builtin_amdgcn_s_setprio(1); _Pragma("unroll") for (int m = 0; m < 4; ++m) _Pragma("unroll") for (int n = 0; n < 2; ++n) { \
        if constexpr (FP8) asm volatile("v_mfma_scale_f32_16x16x128_f8f6f4 %0, %1, %2, %0, %3, %3 op_sel_hi:[0,0,0]" : "+v"(acc[ai][bj][m][n]) : "v"(Bt##8[n]), "v"(At##8[m]), "v"(one8)); \
        else { _Pragma("unroll") for (int k = 0; k < 2; ++k) acc[ai][bj][m][n] = __builtin_amdgcn_mfma_f32_16x16x32_bf16(Bt[n][k], At[m][k], acc[ai][bj][m][n], 0, 0, 0); } } \
        __builtin_amdgcn_s_setprio(0); } while (0)
#define G_WAIT_V(n) asm volatile("s_waitcnt vmcnt(" #n ")" ::: "memory")
#define G_WAIT_L(n) asm volatile("s_waitcnt lgkmcnt(" #n ")" ::: "memory")
#define G_BAR __builtin_amdgcn_s_barrier()
#define G_SCHED __builtin_amdgcn_sched_barrier(0)
    Unit cur, nxt; int ui = 0;
    if (!S.next(0, cur)) return;
    cur.seq = 0; E.unit_begin(cur, lds, wid, lane);
    Acc acc;
#pragma unroll
    for (int a = 0; a < 2; ++a)
#pragma unroll
        for (int b = 0; b < 2; ++b)
#pragma unroll
            for (int m = 0; m < 4; ++m)
#pragma unroll
                for (int n = 0; n < 2; ++n) acc[a][b][m][n] = (f32x4){0.f, 0.f, 0.f, 0.f};
    int one8 = 0x7f7f7f7f; OPAQUE_V(one8);
    bf16x8 At[4][2], B0[2][2], B1[2][2]; i32x8 At8[4], B08[2], B18[2];
    unsigned oC0[2], oC1[2], oN0[2], oN1[2];
#pragma unroll
    for (int i = 0; i < 2; ++i) { oC0[i] = S.a_off(cur, sR[i]) + (unsigned)sC[i] * 2u; oC1[i] = S.a_off(cur, HALF + sR[i]) + (unsigned)sC[i] * 2u; }
    const char* cB = (const char*)S.b_tile(cur);
    G_STAGE(G_SB(0, 0), cB, voffB); G_STAGE(G_SB(0, 1), cB + hstep, voffB); G_STAGE(G_SA(0, 0), Abase, oC0); G_STAGE(G_SA(0, 1), Abase, oC1);
    if (wr == 1) G_BAR;
    G_WAIT_V(2); G_BAR;
    G_STAGE(G_SB(1, 0), cB + kstep, voffB); G_STAGE(G_SA(1, 0), Abase + kstep, oC0); G_STAGE(G_SB(1, 1), cB + hstep + kstep, voffB);
    G_WAIT_V(6); G_BAR;
    for (;;) {
        const bool has_next = S.next(ui + 1, nxt);
        const char* nB = cB;
        if (has_next) nB = (const char*)S.b_tile(nxt);
        if constexpr (!Sched::LATE_OFF) {
#pragma unroll
            for (int i = 0; i < 2; ++i) { oN0[i] = oC0[i]; oN1[i] = oC1[i]; }
            if (has_next) {
#pragma unroll
                for (int i = 0; i < 2; ++i) { oN0[i] = S.a_off(nxt, sR[i]) + (unsigned)sC[i] * 2u; oN1[i] = S.a_off(nxt, HALF + sR[i]) + (unsigned)sC[i] * 2u; } }
        }
        for (int t = 0; t < nt; t += 2) {
            const bool last = (t == nt - 2);
            const char* a1 = Abase + (size_t)(t + 1) * kstep;
            const char* a2 = last ? Abase : Abase + (size_t)(t + 2) * kstep; const char* b2 = last ? nB : cB + (size_t)(t + 2) * kstep;
            const char* a3 = a2 + kstep; const char* b3 = b2 + kstep;
            unsigned o20[2], o21[2];
#pragma unroll
            for (int i = 0; i < 2; ++i) { o20[i] = oC0[i]; o21[i] = oC1[i]; }
            if (last) {
                if constexpr (Sched::LATE_OFF) { if (has_next) {
#pragma unroll
                    for (int i = 0; i < 2; ++i) { o20[i] = S.a_off(nxt, sR[i]) + (unsigned)sC[i] * 2u; o21[i] = S.a_off(nxt, HALF + sR[i]) + (unsigned)sC[i] * 2u; } } }
                else {
#pragma unroll
                    for (int i = 0; i < 2; ++i) { o20[i] = oN0[i]; o21[i] = oN1[i]; } } }
            G_LDB(B0, 0, 0); G_LDB(B1, 0, 1); G_SCHED; G_LDA(At, 0, 0); G_STAGE(G_SA(1, 1), a1, oC1);
            G_WAIT_V(8); G_WAIT_L(0); G_BAR; G_MMA(0, 0, At, B0); G_MMA(0, 1, At, B1); G_BAR; G_SCHED;
            G_LDA(At, 0, 1); G_STAGE(G_SB(0, 0), b2, voffB); G_STAGE(G_SB(0, 1), b2 + hstep, voffB); G_STAGE(G_SA(0, 0), a2, o20);
            G_WAIT_V(8); G_WAIT_L(0); G_BAR; G_MMA(1, 0, At, B0); G_MMA(1, 1, At, B1); G_BAR; G_SCHED;
            G_LDB(B0, 1, 0); G_LDB(B1, 1, 1); G_SCHED; G_LDA(At, 1, 0); G_STAGE(G_SA(0, 1), a2, o21);
            G_WAIT_V(8); G_WAIT_L(0); G_BAR; G_MMA(0, 0, At, B0); G_MMA(0, 1, At, B1); G_BAR; G_SCHED;
            G_LDA(At, 1, 1); G_STAGE(G_SB(1, 0), b3, voffB); G_STAGE(G_SB(1, 1), b3 + hstep, voffB); G_STAGE(G_SA(1, 0), a3, o20);
            G_WAIT_V(8); G_WAIT_L(0); G_BAR; G_MMA(1, 0, At, B0); G_MMA(1, 1, At, B1); G_BAR; G_SCHED;
        }
        if (wr == 0) G_BAR;
        if constexpr (FP8) asm volatile("s_nop 15\n\ts_nop 15\n\ts_nop 15" ::: "memory");
        if constexpr (Epi::FUSED) E.fused(acc, cur, wr, wc, fr, fq, lds, wid, lane); else E(acc, cur, wr, wc, fr, fq);
        if (!has_next) break;
#pragma unroll
        for (int a = 0; a < 2; ++a)
#pragma unroll
            for (int b = 0; b < 2; ++b)
#pragma unroll
                for (int m = 0; m < 4; ++m)
#pragma unroll
                    for (int n = 0; n < 2; ++n) acc[a][b][m][n] = (f32x4){0.f, 0.f, 0.f, 0.f};
        cur = nxt; cB = nB; ++ui; cur.seq = ui; E.unit_begin(cur, lds, wid, lane);
#pragma unroll
        for (int i = 0; i < 2; ++i) { if constexpr (Sched::LATE_OFF) { oC0[i] = S.a_off(cur, sR[i]) + (unsigned)sC[i] * 2u; oC1[i] = S.a_off(cur, HALF + sR[i]) + (unsigned)sC[i] * 2u; } else { oC0[i] = oN0[i]; oC1[i] = oN1[i]; } }
        if (wr == 1) G_BAR;
    }
    G_WAIT_V(0);
    G_BAR;
#undef G_SA
#undef G_SB
#undef G_STAGE
#undef G_LDA
#undef G_LDB
#undef G_MMA
#undef G_LD8
#undef G_WAIT_V
#undef G_WAIT_L
#undef G_BAR
#undef G_SCHED
}

#define GEMM(S, E, K) gemm_mfma(lds, S, E, (K) * 2, wave)
#define GEMM8(S, E, K) gemm_mfma<decltype(S), decltype(E), true>(lds, S, E, (K), wave)

typedef float f32x16 __attribute__((ext_vector_type(16)));
typedef short s16x4 __attribute__((ext_vector_type(4)));
constexpr int AT_NS = 4, AT_K = 0, AT_V = AT_NS * 8192, AT_WS = 2 * AT_NS * 8192, AT_OST = AT_WS + 4096;
constexpr float AT_THR = 8.0f;
__device__ __forceinline__ int crow(int r, int hi) { return (r & 3) + 8 * (r >> 2) + 4 * hi; }
__device__ __forceinline__ s16x4 vtr(LAS unsigned char* p) { return __builtin_bit_cast(s16x4, __builtin_amdgcn_ds_read_tr16_b64_v4i16((LAS s16x4*)p)); }

__device__ __forceinline__ void attn_unit(LAS unsigned char* lds, int b, int kvh, int qblk, const bf16* Q, const bf16* Kb, const bf16* Vb, bf16* AO, const float* sink, const int wid) {
    const int lane = lane_id(), r32 = lane & 31, hi = lane >> 5;
    const int g = wid >> 1, th = wid & 1, hq = kvh * 4 + g;
    const bf16* Kh = Kb + (size_t)b * KROWS * 128 + kvh * 64; const bf16* Vh = Vb + (size_t)b * KROWS * 128 + kvh * 64;
    const int jlo = (qblk == 0) ? 2 : 0, jhi = (qblk == SEQ / 128 - 1) ? 4 : 6, ntile = (jhi - jlo) + 4;
    const size_t tok0 = (size_t)b * SEQ + qblk * 128 + th * 64;
    bf16x8 qr[2][4];
#pragma unroll
    for (int sb = 0; sb < 2; ++sb)
#pragma unroll
        for (int d0 = 0; d0 < 4; ++d0) qr[sb][d0] = *(const bf16x8*)(Q + (tok0 + sb * 32 + r32) * 512 + hq * 64 + d0 * 16 + hi * 8);
    float mhat[2], lreg[2]; f32x16 o[2][2];
#pragma unroll
    for (int sb = 0; sb < 2; ++sb) { mhat[sb] = sink[hq] * LOG2E; lreg[sb] = (hi == 0) ? 1.0f : 0.0f;
#pragma unroll
        for (int d0 = 0; d0 < 2; ++d0)
#pragma unroll
            for (int r = 0; r < 16; ++r) o[sb][d0][r] = 0.f; }
    LAS float* wsf = (LAS float*)(lds + AT_WS + wid * 256);
#define AT_ROWBASE(jj) (((jlo + (jj)) < jhi) ? (CTX + (qblk - 1) * 128 + 64 * (jlo + (jj))) : (64 * (jlo + (jj) - jhi)))
#define AT_DMA(jj, slot) do { int l_ = lane; OPAQUE_V(l_); const size_t rb_ = (size_t)AT_ROWBASE(jj) * 128; \
        __builtin_amdgcn_global_load_lds((const unsigned*)(Kh + rb_ + (size_t)l_ * 128 + wid * 8), (LAS unsigned*)(lds + AT_K + (slot) * 8192 + wid * 1024), 16, 0, 0); \
        __builtin_amdgcn_global_load_lds((const unsigned*)(Vh + rb_ + (size_t)(16 * (wid & 3) + (l_ >> 2)) * 128 + (wid >> 2) * 32 + (l_ & 3) * 8), (LAS unsigned*)(lds + AT_V + (slot) * 8192 + wid * 1024), 16, 0, 0); } while (0)
    AT_DMA(0, 0); AT_DMA(1, 1); AT_DMA(2, 2);
    for (int jj = 0; jj < ntile; ++jj) {
        const int slot = jj & (AT_NS - 1);
        { const int rem = ntile - 1 - jj;
          if (rem >= 2) asm volatile("s_waitcnt vmcnt(4)" ::: "memory"); else if (rem == 1) asm volatile("s_waitcnt vmcnt(2)" ::: "memory"); else asm volatile("s_waitcnt vmcnt(0)" ::: "memory"); }
        __builtin_amdgcn_s_barrier(); asm volatile("" ::: "memory");
        if (jj + 3 < ntile) AT_DMA(jj + 3, (jj + 3) & (AT_NS - 1));
        const int j = jlo + jj;
        bf16x8 kf[8];
        { LAS unsigned char* kp = lds + AT_K + slot * 8192 + hi * 1024 + r32 * 16;
#pragma unroll
          for (int d0 = 0; d0 < 4; ++d0) { kf[2 * d0] = *(const LAS bf16x8*)(kp + d0 * 2048); kf[2 * d0 + 1] = *(const LAS bf16x8*)(kp + d0 * 2048 + 512); } }
        LAS unsigned char* vp = lds + AT_V + slot * 8192 + ((lane >> 4) & 1) * 32 + (lane & 3) * 8 + (4 * hi + ((lane & 15) >> 2)) * 64;
        int lbw = -1000, ubw = 1000;
        if (j < jhi) { if (j == 0) lbw = 0; else if (j == 1) lbw = -64; else if (j == 4) ubw = 0; else if (j == 5) ubw = -64; }
#pragma unroll
        for (int sb = 0; sb < 2; ++sb) {
            __builtin_amdgcn_sched_barrier(0);
            f32x16 p0, p1;
            { const float nm = -mhat[sb];
#pragma unroll
              for (int r = 0; r < 16; ++r) { p0[r] = nm; p1[r] = nm; } }
#pragma unroll
            for (int d0 = 0; d0 < 4; ++d0) { p0 = __builtin_amdgcn_mfma_f32_32x32x16_bf16(kf[2 * d0], qr[sb][d0], p0, 0, 0, 0); p1 = __builtin_amdgcn_mfma_f32_32x32x16_bf16(kf[2 * d0 + 1], qr[sb][d0], p1, 0, 0, 0); }
            if (lbw != -1000 || ubw != 1000) {
                const int qo = th * 64 + sb * 32 + r32; const int lb = (lbw == -1000) ? -1000 : lbw + qo, ub = (ubw == 1000) ? 1000 : ubw + qo;
#pragma unroll
                for (int r = 0; r < 16; ++r) { const int kv = crow(r, hi); if (kv < lb || kv > ub) p0[r] = -1.0e30f; if (kv + 32 < lb || kv + 32 > ub) p1[r] = -1.0e30f; }
            }
            float mx = fmaxf(p0[0], p1[0]);
#pragma unroll
            for (int r = 1; r < 16; ++r) mx = fmaxf(mx, fmaxf(p0[r], p1[r]));
            mx = fmaxf(mx, __shfl_xor(mx, 32));
            if (__builtin_expect(__any(mx > AT_THR), 0)) {
                const float dl = fmaxf(mx, 0.f), f = __builtin_amdgcn_exp2f(-dl); mhat[sb] += dl;
#pragma unroll
                for (int r = 0; r < 16; ++r) { p0[r] -= dl; p1[r] -= dl; }
                lreg[sb] *= f;
                if (hi == 0) wsf[r32] = f;
                asm volatile("s_waitcnt lgkmcnt(0)" ::: "memory");
#pragma unroll
                for (int r = 0; r < 16; ++r) { const float fr_ = wsf[crow(r, hi)]; o[sb][0][r] *= fr_; o[sb][1][r] *= fr_; }
                asm volatile("s_waitcnt lgkmcnt(0)" ::: "memory");
            }
            float ps = 0.f;
#pragma unroll
            for (int r = 0; r < 16; ++r) { p0[r] = __builtin_amdgcn_exp2f(p0[r]); p1[r] = __builtin_amdgcn_exp2f(p1[r]); ps += p0[r] + p1[r]; }
            lreg[sb] += ps;
            u32x4 pw[4];
#pragma unroll
            for (int q = 0; q < 4; ++q) { pw[0][q] = pk2(p0[2 * q], p0[2 * q + 1]); pw[1][q] = pk2(p0[8 + 2 * q], p0[8 + 2 * q + 1]); pw[2][q] = pk2(p1[2 * q], p1[2 * q + 1]); pw[3][q] = pk2(p1[8 + 2 * q], p1[8 + 2 * q + 1]); }
#pragma unroll
            for (int d0 = 0; d0 < 2; ++d0) {
                s16x4 lo[4], hh[4]; const unsigned vb = (unsigned)(uintptr_t)vp;
#pragma unroll
                for (int ks = 0; ks < 4; ++ks) {
                    asm volatile("ds_read_b64_tr_b16 %0, %1 offset:%c2" : "=&v"(lo[ks]) : "v"(vb), "i"(d0 * 4096 + ks * 1024) : "memory");
                    asm volatile("ds_read_b64_tr_b16 %0, %1 offset:%c2" : "=&v"(hh[ks]) : "v"(vb), "i"(d0 * 4096 + ks * 1024 + 512) : "memory"); }
                asm volatile("s_waitcnt lgkmcnt(0)" ::: "memory"); __builtin_amdgcn_sched_barrier(0);
#pragma unroll
                for (int ks = 0; ks < 4; ++ks) { const bf16x8 vf = (bf16x8){lo[ks][0], lo[ks][1], lo[ks][2], lo[ks][3], hh[ks][0], hh[ks][1], hh[ks][2], hh[ks][3]};
                    o[sb][d0] = __builtin_amdgcn_mfma_f32_32x32x16_bf16(__builtin_bit_cast(bf16x8, pw[ks]), vf, o[sb][d0], 0, 0, 0); }
            }
        }
        asm volatile("s_waitcnt lgkmcnt(0)" ::: "memory");
    }
#pragma unroll
    for (int sb = 0; sb < 2; ++sb) {
        const float l = lreg[sb] + __shfl_xor(lreg[sb], 32);
        if (hi == 0) wsf[r32] = 1.0f / l;
        asm volatile("s_waitcnt lgkmcnt(0)" ::: "memory");
        LAS bf16* stg = (LAS bf16*)(lds + AT_OST + wid * 4096);
#pragma unroll
        for (int r = 0; r < 16; ++r) { const int row = crow(r, hi); const float rl = wsf[row];
            stg[row * 64 + r32] = (bf16)(pk2(o[sb][0][r] * rl, 0.f) & 0xffffu); stg[row * 64 + 32 + r32] = (bf16)(pk2(o[sb][1][r] * rl, 0.f) & 0xffffu); }
        asm volatile("s_waitcnt lgkmcnt(0)" ::: "memory");
        bf16* op = AO + (tok0 + sb * 32 + (lane >> 3)) * 512 + hq * 64 + (lane & 7) * 8;
#pragma unroll
        for (int i = 0; i < 4; ++i) { const u32x4 v = *(const LAS u32x4*)(stg + (i * 8 + (lane >> 3)) * 64 + (lane & 7) * 8); *(u32x4*)(op + (size_t)i * 8 * 512) = v; }
        asm volatile("s_waitcnt lgkmcnt(0)" ::: "memory");
    }
    __syncthreads();
#undef AT_ROWBASE
#undef AT_DMA
}

#define XB_TMO      128
#define XB_XCNT(j)  (256  + 64 * (j))
#define XB_XSUB(j)  (1280 + 64 * (j))
#define XB_XGEN(j)  (2304 + 64 * (j))
#define XB_TOP      3328
#define XB_TOPGEN   3392
#define XCD_BAR_WORDS 3456
#define XB_SPIN_CAP (1u << 18)

__device__ __forceinline__ unsigned xb_ld(unsigned* p)              { return __hip_atomic_load(p, __ATOMIC_RELAXED, __HIP_MEMORY_SCOPE_AGENT); }
__device__ __forceinline__ unsigned xb_add(unsigned* p, unsigned v) { return __hip_atomic_fetch_add(p, v, __ATOMIC_RELAXED, __HIP_MEMORY_SCOPE_AGENT); }
__device__ __forceinline__ unsigned xb_xcc_id() { return (unsigned)__builtin_amdgcn_s_getreg((3 << 11) | 20) & 0xFu; }
#define XB_SPIN(cond, bar) do { unsigned _sp = 0; while (cond) { __builtin_amdgcn_s_sleep(1); \
    if ((++_sp & 255u) == 0u) { if (xb_ld(&(bar)[XB_TMO])) break; if (_sp > XB_SPIN_CAP) { atomicAdd(&(bar)[XB_TMO], 1u); break; } } } } while (0)

struct XcdBarrier {
    unsigned* bar; unsigned x;
    volatile LAS unsigned* st;
};

__device__ __forceinline__ XcdBarrier xcd_barrier_post(unsigned* bar, volatile LAS unsigned* st) {
    XcdBarrier b; b.bar = bar; b.x = xb_xcc_id(); b.st = st;
    if (threadIdx.x == 0) (void)xb_add(&bar[XB_XCNT(b.x)], 1u);
    return b;
}
__device__ __forceinline__ void xcd_barrier_complete(unsigned* bar, unsigned x, unsigned& nloc, unsigned& nx) {
    const unsigned G = gridDim.x * gridDim.y * gridDim.z;
    unsigned sum, cnt, mine, sp = 0u;
    for (;;) {
        sum = 0u; cnt = 0u; mine = 0u;
#pragma unroll
        for (unsigned j = 0; j < 16; ++j) { const unsigned c = xb_ld(&bar[XB_XCNT(j)]); sum += c; cnt += (c > 0u) ? 1u : 0u; mine = (j == x) ? c : mine; }
        if (sum == G) break;
        __builtin_amdgcn_s_sleep(1);
        if ((++sp & 255u) == 0u) { if (xb_ld(&bar[XB_TMO])) break; if (sp > XB_SPIN_CAP) { atomicAdd(&bar[XB_TMO], 1u); break; } }
    }
    nloc = mine > 0u ? mine : 1u; nx = cnt > 0u ? cnt : 1u;
}

__device__ __forceinline__ void xcd_barrier(const XcdBarrier& b) {
    asm volatile("s_waitcnt vmcnt(0)" ::: "memory");
    __syncthreads();
    if (threadIdx.x == 0) {
        unsigned* bar = b.bar;
        __builtin_amdgcn_s_waitcnt(0);
        unsigned nloc = b.st[0], nx = b.st[1];
        if (nloc == 0u) { xcd_barrier_complete(bar, b.x, nloc, nx); b.st[0] = nloc; b.st[1] = nx; }
        const unsigned old = xb_add(&bar[XB_XSUB(b.x)], 1u);
        const unsigned gen = old / nloc;
        if (old + 1u == (gen + 1u) * nloc) {
            __builtin_amdgcn_fence(__ATOMIC_RELEASE, "agent");
            asm volatile("s_waitcnt vmcnt(0)" ::: "memory");
            const unsigned og = xb_add(&bar[XB_TOP], 1u);
            const unsigned tg = og / nx;
            if (og + 1u == (tg + 1u) * nx) xb_add(&bar[XB_TOPGEN], 1u);
            else XB_SPIN(xb_ld(&bar[XB_TOPGEN]) == tg, bar);
            __builtin_amdgcn_fence(__ATOMIC_ACQUIRE, "agent");
            xb_add(&bar[XB_XGEN(b.x)], 1u);
            asm volatile("s_waitcnt vmcnt(0)" ::: "memory");
        } else {
            XB_SPIN(xb_ld(&bar[XB_XGEN(b.x)]) == gen, bar);
            __builtin_amdgcn_fence(__ATOMIC_ACQUIRE, "agent");
            asm volatile("s_waitcnt vmcnt(0)" ::: "memory");
        }
    }
    __syncthreads();
}


template <int HW> __device__ __forceinline__ void pool_item(const bf16* Ub, bf16* Dp, int t, int g, int c) {
    const int s = t & (SEQ - 1);
    const bf16* base = Ub + (size_t)(t - s) * 512 + g * 128 + c * 8;
    u32x4 v[2 * HW]; int cnt = 0;
#pragma unroll
    for (int i = 0; i < 2 * HW; ++i) { const int j = s - HW + i; const bool ok = (j >= 0) && (j < SEQ); cnt += ok ? 1 : 0; v[i] = *(const u32x4*)(base + (size_t)(ok ? j : s) * 512); if (!ok) v[i] = (u32x4){0u, 0u, 0u, 0u}; }
    float a[8];
#pragma unroll
    for (int q = 0; q < 8; ++q) a[q] = 0.f;
#pragma unroll
    for (int i = 0; i < 2 * HW; ++i) { a[0] += bflo(v[i].x); a[1] += bfhi(v[i].x); a[2] += bflo(v[i].y); a[3] += bfhi(v[i].y); a[4] += bflo(v[i].z); a[5] += bfhi(v[i].z); a[6] += bflo(v[i].w); a[7] += bfhi(v[i].w); }
    const float rc = 1.0f / (float)cnt; const u32x4 sv = v[HW];
    u32x4 w; w.x = pk2(a[0] * rc - bflo(sv.x), a[1] * rc - bfhi(sv.x)); w.y = pk2(a[2] * rc - bflo(sv.y), a[3] * rc - bfhi(sv.y));
    w.z = pk2(a[4] * rc - bflo(sv.z), a[5] * rc - bfhi(sv.z)); w.w = pk2(a[6] * rc - bflo(sv.w), a[7] * rc - bfhi(sv.w));
    *(u32x4*)(Dp + (size_t)t * 512 + g * 128 + c * 8) = w;
}

template <int CTRL> __device__ __forceinline__ unsigned dpp_u(unsigned v) { return (unsigned)__builtin_amdgcn_update_dpp(0, (int)v, CTRL, 0xf, 0xf, true); }
template <int CTRL> __device__ __forceinline__ float dpp_f(float v) { return __uint_as_float(dpp_u<CTRL>(__float_as_uint(v))); }
constexpr int DPP_XOR1 = 0xB1, DPP_XOR2 = 0x4E, DPP_HMIRROR = 0x141, DPP_MIRROR = 0x140;
__device__ __forceinline__ unsigned long long wave_max_u64(unsigned long long v) {
    unsigned hi = (unsigned)(v >> 32), lo = (unsigned)v;
#define WM_STEP(CTRL) { const unsigned ohi = dpp_u<CTRL>(hi), olo = dpp_u<CTRL>(lo); const bool take = (ohi > hi) || (ohi == hi && olo > lo); hi = take ? ohi : hi; lo = take ? olo : lo; }
    WM_STEP(DPP_XOR1) WM_STEP(DPP_XOR2) WM_STEP(DPP_HMIRROR) WM_STEP(DPP_MIRROR)
#undef WM_STEP
    unsigned long long r = 0;
#pragma unroll
    for (int q = 0; q < 4; ++q) { const unsigned long long c = ((unsigned long long)(unsigned)__builtin_amdgcn_readlane((int)hi, 16 * q) << 32) | (unsigned)__builtin_amdgcn_readlane((int)lo, 16 * q); r = c > r ? c : r; }
    return r;
}
template <int CTRL, int ROWMASK> __device__ __forceinline__ unsigned dpp_rm(unsigned v) { return (unsigned)__builtin_amdgcn_update_dpp((int)v, (int)v, CTRL, ROWMASK, 0xf, false); }
constexpr int DPP_BCAST15 = 0x142, DPP_BCAST31 = 0x143;
__device__ __forceinline__ unsigned wave_max_u32(unsigned v) {
    v = max(v, dpp_u<DPP_XOR1>(v)); v = max(v, dpp_u<DPP_XOR2>(v)); v = max(v, dpp_u<DPP_HMIRROR>(v)); v = max(v, dpp_u<DPP_MIRROR>(v));
    v = max(v, dpp_rm<DPP_BCAST15, 0xa>(v)); v = max(v, dpp_rm<DPP_BCAST31, 0xc>(v));
    return (unsigned)__builtin_amdgcn_readlane((int)v, 63);
}
__device__ __forceinline__ unsigned wave_min_u32(unsigned v) {
    v = min(v, dpp_u<DPP_XOR1>(v)); v = min(v, dpp_u<DPP_XOR2>(v)); v = min(v, dpp_u<DPP_HMIRROR>(v)); v = min(v, dpp_u<DPP_MIRROR>(v));
    v = min(v, dpp_rm<DPP_BCAST15, 0xa>(v)); v = min(v, dpp_rm<DPP_BCAST31, 0xc>(v));
    return (unsigned)__builtin_amdgcn_readlane((int)v, 63);
}
__device__ __forceinline__ unsigned f2sortable(float f) { const unsigned u = __float_as_uint(f); return (u & 0x80000000u) ? ~u : (u | 0x80000000u); }

struct TItem { const float* src; bf16* dst; int N, pitch; bool perm; int blk; float q8; };
__device__ __forceinline__ TItem titem_decode(const Params& p, int it, bf16* Win_t, bf16* Wua_t, bf16* Wout_t, bf16* Wr_t, bf16* Wgu_t, bf16* Wd_t) {
    constexpr int I0 = 1664, I1 = 256, I2 = 512, I3 = 128, IE = 384;
    TItem t; t.blk = -1; t.q8 = 0.f; int r = it;
    if (r < I0) { const int kb = r / 104, n0 = (r % 104) * 32; t.src = p.in[7] + (size_t)kb * 64 * IN_DIM + n0; t.N = IN_DIM; t.dst = Win_t + (size_t)n0 * 1024 + kb * 64; t.pitch = 1024; t.perm = n0 >= 768; return t; } r -= I0;
    if (r < I1) { const int kb = r / 32, n0 = (r % 32) * 32; t.src = p.in[11] + (size_t)kb * 64 * 1024 + n0; t.N = 1024; t.dst = Wua_t + (size_t)n0 * 512 + kb * 64; t.pitch = 512; t.perm = true; return t; } r -= I1;
    if (r < I2) { const int kb = r / 32, n0 = (r % 32) * 32; t.src = p.in[13] + (size_t)kb * 64 * 1024 + n0; t.N = 1024; t.dst = Wout_t + (size_t)n0 * 1024 + kb * 64; t.pitch = 1024; t.perm = true; return t; } r -= I2;
    if (r < I3) { const int kb = r / 8, n0 = (r % 8) * 32; t.src = p.in[15] + (size_t)kb * 64 * 256 + n0; t.N = 256; t.dst = Wr_t + (size_t)n0 * 1024 + kb * 64; t.pitch = 1024; t.perm = false; return t; } r -= I3;
    const int e = r / IE, q = r % IE, which = q >> 7, qi = q & 127;
    if (which < 2) {
        const float* W = (e < 256) ? p.in[17 + which] + (size_t)e * 1024 * 256 : p.in[20 + which];
        const int kb = qi / 8, n0 = (qi % 8) * 32; const int rowbase = 256 * (n0 >> 7) + (n0 & 96) + which * 128;
        t.src = W + (size_t)kb * 64 * 256 + n0; t.N = 256; t.dst = (bf16*)((unsigned char*)Wgu_t + (size_t)e * 512 * 1024 + (size_t)rowbase * 1024 + kb * 64); t.pitch = 1024; t.perm = true; t.q8 = WQ8;
    } else {
        const float* W = (e < 256) ? p.in[19] + (size_t)e * 256 * 1024 : p.in[22];
        const int kb = qi / 32, n0 = (qi % 32) * 32;
        t.src = W + (size_t)kb * 64 * 1024 + n0; t.N = 1024; t.dst = (bf16*)((unsigned char*)Wd_t + (size_t)e * 1024 * 256 + (size_t)(n0 & ~255) * 256 + kb * 64); t.pitch = 256; t.perm = true; t.blk = (n0 & 255) >> 5; t.q8 = WDQ8;
    }
    return t;
}
__device__ __forceinline__ void titem_load(const TItem& t, f32x4 (&v)[8], int lane) {
    const float* src = t.src + (size_t)(lane >> 3) * t.N + (lane & 7) * 4;
#pragma unroll
    for (int i = 0; i < 8; ++i) v[i] = __builtin_nontemporal_load((const f32x4*)(src + (size_t)(8 * i) * t.N));
}
__device__ __forceinline__ void titem_finish(const TItem& t, const f32x4 (&v)[8], LAS float* scr, int lane) {
#pragma unroll
    for (int i = 0; i < 8; ++i) { LAS float* d = scr + (8 * i + (lane >> 3)) * 33 + (lane & 7) * 4; d[0] = v[i].x; d[1] = v[i].y; d[2] = v[i].z; d[3] = v[i].w; }
    asm volatile("s_waitcnt lgkmcnt(0)" ::: "memory");
    const int c = lane & 7;
#pragma unroll
    for (int j = 0; j < 4; ++j) { const int n = (lane >> 3) + 8 * j; const LAS float* s = scr + (8 * c) * 33 + n;
        int row = t.perm ? invperm32(n) : n;
        if (t.blk >= 0) row = 128 * ((n >> 3) & 1) + 32 * (t.blk >> 1) + 16 * ((n >> 2) & 1) + 4 * (2 * (t.blk & 1) + (n >> 4)) + (n & 3);
        if (t.q8 != 0.f) { const float q = t.q8; int lo = 0, hi = 0;
            lo = __builtin_amdgcn_cvt_pk_fp8_f32(s[0 * 33] * q, s[1 * 33] * q, lo, false); lo = __builtin_amdgcn_cvt_pk_fp8_f32(s[2 * 33] * q, s[3 * 33] * q, lo, true);
            hi = __builtin_amdgcn_cvt_pk_fp8_f32(s[4 * 33] * q, s[5 * 33] * q, hi, false); hi = __builtin_amdgcn_cvt_pk_fp8_f32(s[6 * 33] * q, s[7 * 33] * q, hi, true);
            *(u32x2*)((unsigned char*)t.dst + (size_t)row * t.pitch + 8 * c) = (u32x2){(unsigned)lo, (unsigned)hi}; }
        else { u32x4 o; o.x = pk2(s[0 * 33], s[1 * 33]); o.y = pk2(s[2 * 33], s[3 * 33]); o.z = pk2(s[4 * 33], s[5 * 33]); o.w = pk2(s[6 * 33], s[7 * 33]);
            *(u32x4*)(t.dst + (size_t)row * t.pitch + 8 * c) = o; } }
    asm volatile("s_waitcnt lgkmcnt(0)" ::: "memory");
}

template <int NR> __device__ __forceinline__ void adaln_rows(const float* xrow, const float* g, const float* sc, const float* sh, bf16* orow, int lane) {
    f32x4 v[NR][4]; float rstd[NR];
#pragma unroll
    for (int r = 0; r < NR; ++r)
#pragma unroll
        for (int j = 0; j < 4; ++j) v[r][j] = __builtin_nontemporal_load((const f32x4*)(xrow + (size_t)r * D) + 64 * j + lane);
#pragma unroll
    for (int r = 0; r < NR; ++r) { float s = 0.f;
#pragma unroll
        for (int j = 0; j < 4; ++j) s += (v[r][j].x * v[r][j].x + v[r][j].y * v[r][j].y) + (v[r][j].z * v[r][j].z + v[r][j].w * v[r][j].w);
        rstd[r] = 1.0f / sqrtf(wave_sum(s) * (1.0f / D) + NORM_EPS); }
#pragma unroll
    for (int j = 0; j < 4; ++j) {
        const int c4 = 64 * j + lane;
        const f32x4 gv = *((const f32x4*)g + c4), scv = *((const f32x4*)sc + c4) + 1.0f, shv = *((const f32x4*)sh + c4);
#pragma unroll
        for (int r = 0; r < NR; ++r) { const f32x4 h = ((v[r][j] * rstd[r]) * gv) * scv + shv; u32x2 w; w.x = pk2(h.x, h.y); w.y = pk2(h.z, h.w); *((u32x2*)(orow + (size_t)r * D) + c4) = w; }
    }
}


constexpr int NIT_ALL = 1664 + 256 + 512 + 128 + 257 * 384;
constexpr int P1_GEMM_WGS = 168, P1_FULL_WGS = 1672 - 9 * P1_GEMM_WGS;
constexpr int BGA_PER_WAVE = 95, BG1_PER_WAVE = 14, BG2_PER_WAVE = 14;
constexpr int BGA_ITEMS = (256 - P1_GEMM_WGS) * 8 * BGA_PER_WAVE, BG1_ITEMS = (P1_GEMM_WGS - P1_FULL_WGS) * 8 * BG1_PER_WAVE, BG2_ITEMS = 128 * 8 * BG2_PER_WAVE;
static_assert(BGA_ITEMS + BG1_ITEMS + BG2_ITEMS <= 257 * 384, "background items are expert items");
#define TRANSPOSE_RANGE(first, stride, end) do { \
        const int lane_t = lane_id(); LAS float* scr_ = (LAS float*)(lds + wave * 8448); \
        int it_ = (first); const int end_ = (end), str_ = (stride); \
        if (it_ < end_) { \
            TItem c0_ = titem_decode(p, it_, Win_t, Wua_t, Wout_t, Wr_t, Wgu_t, Wd_t), c1_ = c0_, c2_ = c0_; \
            f32x4 v0_[8], v1_[8], v2_[8]; titem_load(c0_, v0_, lane_t); \
            if (it_ + str_ < end_) { c1_ = titem_decode(p, it_ + str_, Win_t, Wua_t, Wout_t, Wr_t, Wgu_t, Wd_t); titem_load(c1_, v1_, lane_t); } \
            for (;;) { \
                const int it2_ = it_ + 2 * str_; \
                if (it2_ < end_) { c2_ = titem_decode(p, it2_, Win_t, Wua_t, Wout_t, Wr_t, Wgu_t, Wd_t); titem_load(c2_, v2_, lane_t); } \
                titem_finish(c0_, v0_, scr_, lane_t); \
                it_ += str_; if (it_ >= end_) break; \
                c0_ = c1_; c1_ = c2_; \
                _Pragma("unroll") for (int i_ = 0; i_ < 8; ++i_) { v0_[i_] = v1_[i_]; v1_[i_] = v2_[i_]; } \
            } } } while (0)

constexpr int LDS_BYTES = 147456;
constexpr int LDS_TAB = 131072;

__global__ void __launch_bounds__(512, 2) fwd_kernel(Params p) {
    extern __shared__ __attribute__((aligned(16))) unsigned char lds_raw[];
    LAS unsigned char* lds = (LAS unsigned char*)lds_raw;
    const int wave = __builtin_amdgcn_readfirstlane(threadIdx.x >> 6);
    const int G = gridDim.x, bx = blockIdx.x;
    const int vcu = (G % 8 == 0) ? (bx % 8) * (G / 8) + bx / 8 : bx;
    const int gw = vcu * 8 + wave, NGW = G * 8;
    unsigned char* ws = p.ws;
    int* g_cnt = (int*)(ws + WS_CNT);
    f32x2* g_rope = (f32x2*)(ws + WS_ROPE);
    float* g_mod = (float*)(ws + WS_MOD);
    bf16* Win_t = (bf16*)(ws + WS_WIN); bf16* Wua_t = (bf16*)(ws + WS_WUA); bf16* Weff_t = (bf16*)(ws + WS_WEFF); bf16* Wout_t = (bf16*)(ws + WS_WOUT);
    bf16* Wr_t = (bf16*)(ws + WS_WR); bf16* Wd_t = (bf16*)(ws + WS_WD); bf16* Wgu_t = (bf16*)(ws + WS_WGU);
    bf16* Yb = (bf16*)(ws + WS_Y); bf16* Gt = (bf16*)(ws + WS_G); float* Lg = (float*)(ws + WS_LOGIT); bf16* Hn = (bf16*)(ws + WS_H);
    bf16* Qb = (bf16*)(ws + WS_Q); bf16* AO = (bf16*)(ws + WS_AO); bf16* Ub = (bf16*)(ws + WS_U); bf16* Dp = (bf16*)(ws + WS_DP);
    bf16* Kb = (bf16*)(ws + WS_K); bf16* Vb = (bf16*)(ws + WS_V); bf16* T1 = (bf16*)(ws + WS_T1); bf16* Ysh = (bf16*)(ws + WS_YSH);
    bf16* Hb = (bf16*)(ws + WS_HB); int* ldst = (int*)(ws + WS_LDST); float* lw = (float*)(ws + WS_LW); bf16* H2 = (bf16*)(ws + WS_H2);
    const float* x = p.in[0];

    volatile LAS unsigned* bst = (volatile LAS unsigned*)(lds + LDS_TAB + 4096);
    { const int l0 = lane_id(); if (wave == 0 && l0 < 2) bst[l0] = 0u; }
    __syncthreads();
    XcdBarrier xbar = xcd_barrier_post((unsigned*)(ws + WS_BAR), bst);
#define GRID_BAR() xcd_barrier(xbar)
    {
        const int lane = lane_id(), tid = wave * 64 + lane;
        if (bx == 0 && tid < NE) g_cnt[tid] = 0;
        if (bx == 1) {
            for (int i = tid; i < 1024; i += 512) { const int pos = i >> 4, f = i & 15;
                const float inv = powf(10000.0f, -(float)f / 16.0f); const float ang = (float)pos * inv;
                g_rope[i] = (f32x2){(float)cos((double)ang), (float)sin((double)ang)}; }
        }
        if (bx * 24 < 6144) {
            LAS float* sl = (LAS float*)lds;
            LAS float* red = (LAS float*)(lds + 36864);
            for (int i = tid; i < 9 * 1024; i += 512) { const int r = i >> 10, k = i & 1023; const float cv = (r < 8) ? p.in[1][r * 1024 + k] : p.in[3][k]; sl[i] = cv * sigmoidf_(cv); }
            __syncthreads();
            const int ks = tid >> 3, ct = tid & 7; float a[9][3];
#pragma unroll
            for (int r = 0; r < 9; ++r) { a[r][0] = 0.f; a[r][1] = 0.f; a[r][2] = 0.f; }
            const float* wa = p.in[4] + bx * 24 + 3 * ct;
            for (int kk = 0; kk < 16; ++kk) { const int k = ks * 16 + kk; const float w0 = wa[(size_t)k * 6144], w1 = wa[(size_t)k * 6144 + 1], w2 = wa[(size_t)k * 6144 + 2];
#pragma unroll
                for (int r = 0; r < 9; ++r) { const float s = sl[r * 1024 + k]; a[r][0] += s * w0; a[r][1] += s * w1; a[r][2] += s * w2; } }
#pragma unroll
            for (int r = 0; r < 9; ++r)
#pragma unroll
                for (int c = 0; c < 3; ++c) red[ks * 216 + ct * 27 + r * 3 + c] = a[r][c];
            __syncthreads();
            if (tid < 216) { float s = 0.f; for (int k2 = 0; k2 < 64; ++k2) s += red[k2 * 216 + tid];
                const int ct2 = tid / 27, r = (tid % 27) / 3, c = tid % 3; const int n = bx * 24 + 3 * ct2 + c;
                g_mod[r * 6144 + n] = s + p.in[5][n]; }
            __syncthreads();
        }
        TRANSPOSE_RANGE(gw, NGW, (G == 256 ? NIT_ALL - BGA_ITEMS - BG1_ITEMS - BG2_ITEMS : NIT_ALL));
        {
            const int gt = vcu * 512 + tid;
            if (gt < 131072) {
                const int n = gt & 1023, kg = gt >> 10, g = kg >> 5, c0 = (kg & 31) * 4;
                float a0 = 0.f, a1 = 0.f, a2 = 0.f, a3 = 0.f;
                const float* wp = p.in[9] + (size_t)g * 128 * 128 + (size_t)c0 * 128;
#pragma unroll 16
                for (int d = 0; d < 128; ++d) {
                    const float t = p.in[10][g * 128 + d] * p.in[12][(size_t)(g * 128 + d) * 1024 + n];
                    a0 += wp[d] * t; a1 += wp[128 + d] * t; a2 += wp[256 + d] * t; a3 += wp[384 + d] * t;
                }
                const int row = (n & ~31) + invperm32(n & 31);
                u32x2 w; w.x = pk2(a0, a1); w.y = pk2(a2, a3);
                *(u32x2*)(Weff_t + (size_t)row * 512 + g * 128 + c0) = w;
            }
        }
    }
    GRID_BAR();

    { const int lane = lane_id(); const float* g1n = p.in[6];
      for (int q = gw; q < (T + TC) / 4; q += NGW) { const int m = q * 4;
          if (m < T) { const int b = m >> 12; adaln_rows<4>(x + (size_t)m * D, g1n, g_mod + b * 6144 + 1024, g_mod + b * 6144, Hn + (size_t)m * D, lane); }
          else adaln_rows<4>(p.in[2] + (size_t)(m - T) * D, g1n, g_mod + 8 * 6144 + 1024, g_mod + 8 * 6144, Hn + (size_t)m * D, lane); } }
    GRID_BAR();

    {
        EpiProj E{Qb, Kb, Vb, Ub, Gt, g_rope};
        if (G != 256) { DenseSched S{Hn, Win_t, 2048, 128, 13, G, bx, 8, 128, 2}; GEMM(S, E, 1024); }
        else if (bx < P1_GEMM_WGS) {
            DenseSched S{Hn, Win_t, 2048, 128, 13, P1_GEMM_WGS, bx, 8, 128, 2}; GEMM(S, E, 1024);
            if (bx >= P1_FULL_WGS) { const int w0 = NIT_ALL - BG1_ITEMS - BG2_ITEMS + (bx - P1_FULL_WGS) * 8 + wave; TRANSPOSE_RANGE(w0, (P1_GEMM_WGS - P1_FULL_WGS) * 8, NIT_ALL - BG2_ITEMS); }
        } else { const int w0 = NIT_ALL - BGA_ITEMS - BG1_ITEMS - BG2_ITEMS + (bx - P1_GEMM_WGS) * 8 + wave; TRANSPOSE_RANGE(w0, (256 - P1_GEMM_WGS) * 8, NIT_ALL - BG1_ITEMS - BG2_ITEMS); }
    }
    GRID_BAR();

    {
        for (int uidx = vcu; uidx < NB * 2 * (SEQ / 128); uidx += G) {
            const int qblk = uidx & 31, kvh = (uidx >> 5) & 1, b = uidx >> 6;
            attn_unit(lds, b, kvh, qblk, Qb, Kb, Vb, AO, p.in[8], wave);
        }
        { const int lane = lane_id();
          for (int it = gw; it < T; it += NGW) {
              const int g = it & 3, t = (it >> 2) * 4 + (lane >> 4), c = lane & 15;
              if (g == 0) pool_item<1>(Ub, Dp, t, g, c); else if (g == 1) pool_item<2>(Ub, Dp, t, g, c); else if (g == 2) pool_item<4>(Ub, Dp, t, g, c); else pool_item<8>(Ub, Dp, t, g, c);
          } }
    }
    GRID_BAR();

    { PairSched S{AO, Dp, Wua_t, Weff_t, 1024, 128, 4, G, bx}; EpiGate E{T1, Gt}; GEMM(S, E, 512); }
    GRID_BAR();
    { DenseSched S{T1, Wout_t, 2048, 128, 4, G, bx, 0, 0, 0}; EpiX1F E{x, g_mod, (bf16*)(ws + WS_X1B), H2, p.in[14], (float*)(ws + WS_SLOT), (unsigned*)(ws + WS_PCNT), ws + WS_H2Q}; GEMM(S, E, 1024); }
    GRID_BAR();
    { DenseSched S{H2, Wr_t, 2048, 128, 1, G, bx, 0, 0, 0}; EpiLogit E{Lg}; GEMM(S, E, 1024);
      if (G == 256 && bx >= 128) { const int w0 = NIT_ALL - BG2_ITEMS + (bx - 128) * 8 + wave; TRANSPOSE_RANGE(w0, 1024, NIT_ALL); } }
    GRID_BAR();
    {
        const int lane = lane_id(), tid = wave * 64 + lane;
        LAS int* lhist = (LAS int*)lds; LAS int* gbase = (LAS int*)(lds + 1024); LAS int* sel_e = (LAS int*)(lds + 2048); LAS float* sel_w = (LAS float*)(lds + 6144); LAS int* sel_pos = (LAS int*)(lds + 10240);
        const int tpb = T / G, tpw = tpb / 8, tb0 = vcu * tpb;
        if (tid < 256) lhist[tid] = 0;
        __syncthreads();
        const f32x4 rb = *((const f32x4*)p.in[16] + lane);
        for (int i = 0; i < tpw; i += 2) {
            float sg[2][4], sel[2][4], m1[2], m2[2], gs[2]; unsigned kv[2][4]; int my_e[2]; float my_s[2], ssum[2];
#pragma unroll
            for (int q = 0; q < 2; ++q) { const f32x4 lg = *((const f32x4*)(Lg + (size_t)(tb0 + wave * tpw + i + q) * 256) + lane);
#pragma unroll
                for (int j = 0; j < 4; ++j) { sg[q][j] = sigmoidf_(lg[j]); sel[q][j] = sg[q][j] + rb[j]; }
                m1[q] = fmaxf(sel[q][0], sel[q][1]); m2[q] = fminf(sel[q][0], sel[q][1]);
#pragma unroll
                for (int j = 2; j < 4; ++j) { const float v = sel[q][j]; m2[q] = fmaxf(m2[q], fminf(m1[q], v)); m1[q] = fmaxf(m1[q], v); } }
#define MERGE2(CTRL) { _Pragma("unroll") for (int q = 0; q < 2; ++q) { const float p1 = dpp_f<CTRL>(m1[q]), p2 = dpp_f<CTRL>(m2[q]); const float n1 = fmaxf(m1[q], p1); m2[q] = fmaxf(fminf(m1[q], p1), fmaxf(m2[q], p2)); m1[q] = n1; } }
            MERGE2(DPP_XOR1) MERGE2(DPP_XOR2) MERGE2(DPP_HMIRROR)
#undef MERGE2
            const int g = lane >> 3;
#pragma unroll
            for (int q = 0; q < 2; ++q) { gs[q] = m1[q] + m2[q]; int rank = 0;
#pragma unroll
                for (int g2 = 0; g2 < 8; ++g2) { const float o = __uint_as_float((unsigned)__builtin_amdgcn_readlane((int)__float_as_uint(gs[q]), g2 * 8)); rank += (o > gs[q] || (o == gs[q] && g2 < g)) ? 1 : 0; }
                const bool gsel = rank < 4;
#pragma unroll
                for (int j = 0; j < 4; ++j) kv[q][j] = gsel ? f2sortable(sel[q][j]) : 0u;
                my_e[q] = 0; my_s[q] = 0.f; ssum[q] = 0.f; }
#pragma unroll
            for (int k = 0; k < TOPK; ++k) {
                unsigned wmax[2], ci[2]; int gi[2];
#pragma unroll
                for (int q = 0; q < 2; ++q) wmax[q] = wave_max_u32(max(max(kv[q][0], kv[q][1]), max(kv[q][2], kv[q][3])));
#pragma unroll
                for (int q = 0; q < 2; ++q) { ci[q] = 0xffffu;
#pragma unroll
                    for (int j = 3; j >= 0; --j) ci[q] = (kv[q][j] == wmax[q]) ? (unsigned)(lane * 4 + j) : ci[q]; }
#pragma unroll
                for (int q = 0; q < 2; ++q) gi[q] = (int)wave_min_u32(ci[q]);
#pragma unroll
                for (int q = 0; q < 2; ++q) { const int owner = gi[q] >> 2, oj = gi[q] & 3;
                    const float svl = (oj == 0) ? sg[q][0] : (oj == 1) ? sg[q][1] : (oj == 2) ? sg[q][2] : sg[q][3];
                    const float sv = __uint_as_float((unsigned)__builtin_amdgcn_readlane((int)__float_as_uint(svl), owner));
                    const bool mine = lane == owner;
#pragma unroll
                    for (int j = 0; j < 4; ++j) kv[q][j] = (mine && oj == j) ? 0u : kv[q][j];
                    my_e[q] = (lane == k) ? gi[q] : my_e[q]; my_s[q] = (lane == k) ? sv : my_s[q];
                    ssum[q] += sv; }
            }
            if (lane < TOPK) {
#pragma unroll
                for (int q = 0; q < 2; ++q) { const int tl = wave * tpw + i + q;
                    const int lp = __hip_atomic_fetch_add(&lhist[my_e[q]], 1, __ATOMIC_RELAXED, __HIP_MEMORY_SCOPE_WORKGROUP);
                    sel_e[tl * 8 + lane] = my_e[q]; sel_w[tl * 8 + lane] = my_s[q] / ssum[q] * 2.5f; sel_pos[tl * 8 + lane] = lp; }
            }
        }
        __syncthreads();
        if (tid < 256) { const int c = lhist[tid]; gbase[tid] = c ? atomicAdd(&g_cnt[tid], c) : 0; }
        __syncthreads();
        for (int i = tid; i < tpb * 8; i += 512) { const int e = sel_e[i]; const int pos = gbase[e] + sel_pos[i];
            ldst[(size_t)e * CAP + pos] = (tb0 + (i >> 3)) * 8 + (i & 7); lw[(size_t)e * CAP + pos] = sel_w[i]; }
    }
    GRID_BAR();

    LAS int* tp = (LAS int*)(lds + LDS_TAB); LAS int* lcnt = (LAS int*)(lds + LDS_TAB + 2048);
    {
        const int tid = wave * 64 + lane_id();
        if (tid < 257) lcnt[tid] = (tid < 256) ? __hip_atomic_load(&g_cnt[tid], __ATOMIC_RELAXED, __HIP_MEMORY_SCOPE_AGENT) : T;
        __syncthreads();
        if (tid == 0) { int s = 0; for (int e = 0; e < 257; ++e) { tp[e] = s; s += (lcnt[e] + 255) >> 8; } tp[257] = s; }
        __syncthreads();
    }
    { GroupSched S{tp, lcnt, ws + WS_H2Q, Wgu_t, ldst, 1024, 2, G, vcu, (size_t)512 * 1024, true, lds}; S.prepare(lds, wave * 64 + lane_id()); EpiH E{(unsigned char*)Hb, 1.0f / (WQ8 * AQ8)}; GEMM8(S, E, 1024); }
    GRID_BAR();
    { GroupSched S{tp, lcnt, Hb, Wd_t, ldst, 256, 4, G, vcu, (size_t)1024 * 256, false, lds}; S.prepare(lds, wave * 64 + lane_id()); EpiY E{(unsigned char*)Yb, (unsigned char*)Ysh, ldst, lw, lcnt, 1.0f / (WDQ8 * HQ8)}; GEMM8(S, E, 256); }
    GRID_BAR();

    {
        const int lane = lane_id(); const unsigned char* Y8 = (const unsigned char*)Yb; const unsigned char* Ysh8 = (const unsigned char*)Ysh;
        for (int t = gw; t < T; t += NGW) {
            const int b = t >> 12; float* xr = p.out + (size_t)t * D + lane * 16; const bf16* x1r = (const bf16*)(ws + WS_X1B) + (size_t)t * D + lane * 16;
            u32x4 yv[9]; f32x4 xv[4];
#pragma unroll
            for (int k = 0; k < 8; ++k) yv[k] = __builtin_nontemporal_load((const u32x4*)(Y8 + ((size_t)t * 8 + k) * 1024) + lane);
            yv[8] = __builtin_nontemporal_load((const u32x4*)(Ysh8 + (size_t)t * 1024) + lane);
            { const u32x4 xa = *((const u32x4*)x1r), xb = *((const u32x4*)x1r + 1);
              xv[0] = (f32x4){bflo(xa.x), bfhi(xa.x), bflo(xa.y), bfhi(xa.y)}; xv[1] = (f32x4){bflo(xa.z), bfhi(xa.z), bflo(xa.w), bfhi(xa.w)};
              xv[2] = (f32x4){bflo(xb.x), bfhi(xb.x), bflo(xb.y), bfhi(xb.y)}; xv[3] = (f32x4){bflo(xb.z), bfhi(xb.z), bflo(xb.w), bfhi(xb.w)}; }
            float f[16];
#pragma unroll
            for (int i = 0; i < 16; ++i) f[i] = 0.f;
#pragma unroll
            for (int k = 0; k < 9; ++k)
#pragma unroll
                for (int q = 0; q < 4; ++q) { const f32x2 lo = __builtin_amdgcn_cvt_pk_f32_fp8((int)yv[k][q], false), hi = __builtin_amdgcn_cvt_pk_f32_fp8((int)yv[k][q], true);
                    f[4 * q] += lo.x; f[4 * q + 1] += lo.y; f[4 * q + 2] += hi.x; f[4 * q + 3] += hi.y; }
            const float* g2p = g_mod + b * 6144 + 5120 + lane * 16; float s = 0.f;
#pragma unroll
            for (int q = 0; q < 4; ++q) { const f32x4 g2 = *((const f32x4*)g2p + q) * (1.0f / YSCALE);
                xv[q] = xv[q] + g2 * (f32x4){f[4 * q], f[4 * q + 1], f[4 * q + 2], f[4 * q + 3]};
                s += (xv[q].x * xv[q].x + xv[q].y * xv[q].y) + (xv[q].z * xv[q].z + xv[q].w * xv[q].w); }
            const float rstd = 1.0f / sqrtf(wave_sum(s) * (1.0f / D) + NORM_EPS);
#pragma unroll
            for (int q = 0; q < 4; ++q) { const f32x4 fg = *((const f32x4*)(p.in[23] + lane * 16) + q); *((f32x4*)xr + q) = (xv[q] * rstd) * fg; }
        }
    }
}

extern "C" void kernel_launch(void* const* d_in, const int* in_sizes, int n_in, void* d_out, int out_size, void* d_ws, size_t ws_size, hipStream_t stream) {
    static int grid = 0;
    if (grid == 0) {
        if (n_in != 24 || ws_size < WS_END) { fprintf(stderr, "kernel_launch: unexpected n_in %d or ws_size %zu (need %zu)\n", n_in, ws_size, (size_t)WS_END); grid = -1; return; }
        int dev = 0, cus = 0, per_cu = 0;
        (void)hipGetDevice(&dev); (void)hipDeviceGetAttribute(&cus, hipDeviceAttributeMultiprocessorCount, dev);
        (void)hipFuncSetAttribute((const void*)fwd_kernel, hipFuncAttributeMaxDynamicSharedMemorySize, LDS_BYTES);
        (void)hipOccupancyMaxActiveBlocksPerMultiprocessor(&per_cu, (const void*)fwd_kernel, 512, LDS_BYTES);
        if (per_cu < 1) { fprintf(stderr, "kernel_launch: occupancy query says %d blocks per CU\n", per_cu); per_cu = 1; }
        (void)hipGetLastError();
        grid = cus;
    }
    if (grid < 0) return;
    (void)hipMemsetAsync((char*)d_ws + WS_BAR, 0, WS_BAR_BYTES, stream);
    Params p{};
    for (int i = 0; i < 24; ++i) p.in[i] = (const float*)d_in[i];
    p.out = (float*)d_out; p.ws = (unsigned char*)d_ws;
    void* args[] = {&p};
    hipError_t e = hipLaunchCooperativeKernel((const void*)fwd_kernel, dim3(grid), dim3(512), args, LDS_BYTES, stream);
    if (e != hipSuccess) fprintf(stderr, "cooperative launch failed: %s (grid %d)\n", hipGetErrorString(e), grid);
}
```
